# Optimizing an MI355X kernel written in HIP

```python
import math
import jax, jax.numpy as jnp
from jax import lax
import numpy as np

D_MODEL = 1024
BATCH = 2
SEQ = 8192
DEPTH = 2

HEAD_DIM = 64
D_MIX = D_MODEL
N_HEADS_TOTAL = D_MIX // HEAD_DIM
N_HEADS_DIL = N_HEADS_TOTAL // 2
N_LRU_BLOCKS = N_HEADS_TOTAL // 4
N_HEADS_SB = N_HEADS_TOTAL // 4
W_DIL = N_HEADS_DIL * HEAD_DIM
W_LRU = N_LRU_BLOCKS * HEAD_DIM
W_SB = N_HEADS_SB * HEAD_DIM
D_IN = 4 * W_DIL + 2 * W_LRU + 4 * W_SB
ROPE_DIM = HEAD_DIM // 4
ROPE_THETA = 500000.0
DILATED_PATTERNS = ((128, 1), (512, 4), (2048, 16))
CONV_WIDTH = 4
LRU_C = 8.0
Q_BLOCK = 128
EPS = 1e-6

kernel_name = 'hybrid_dilated_rglru_stickbreaking'


def _in_split_points():
    sizes = [W_DIL] * 4 + [W_LRU] * 2 + [W_SB] * 4
    points, acc = [], 0
    for s in sizes[:-1]:
        acc += s
        points.append(acc)
    return points


def rms_norm(x, gain):
    xf = x.astype(jnp.float32)
    xf = xf * lax.rsqrt(jnp.mean(xf * xf, axis=-1, keepdims=True) + EPS)
    return (xf * gain.astype(jnp.float32)).astype(x.dtype)


def rope_tables(seq_len):
    pos = jnp.arange(seq_len, dtype=jnp.float32)
    inv_freq = ROPE_THETA ** (-jnp.arange(0, ROPE_DIM, 2, dtype=jnp.float32) / ROPE_DIM)
    ang = pos[:, None] * inv_freq[None, :]
    return jnp.cos(ang), jnp.sin(ang)


def apply_partial_rope(x, cos, sin):
    half = ROPE_DIM // 2
    xf = x.astype(jnp.float32)
    x1 = xf[..., :half]
    x2 = xf[..., half:ROPE_DIM]
    c = cos[None, :, None, :]
    s = sin[None, :, None, :]
    out = jnp.concatenate([x1 * c - x2 * s, x2 * c + x1 * s, xf[..., ROPE_DIM:]], axis=-1)
    return out.astype(x.dtype)


def dilated_attention(q, k, v):
    b, h, seq, _ = q.shape
    scale = 1.0 / math.sqrt(HEAD_DIM)
    offs = jnp.arange(Q_BLOCK)

    def block(blk):
        t = blk * Q_BLOCK + offs
        q_blk = lax.dynamic_slice_in_dim(q, blk * Q_BLOCK, Q_BLOCK, axis=2).astype(jnp.float32) * scale
        lses, outs = [], []
        for window, dilation in DILATED_PATTERNS:
            n_keys = window // dilation + 1
            idx = t[:, None] - dilation * jnp.arange(n_keys)[None, :]
            valid = idx >= 0
            idx = jnp.maximum(idx, 0)
            k_g = jnp.take(k, idx, axis=2).astype(jnp.float32)
            v_g = jnp.take(v, idx, axis=2).astype(jnp.float32)
            s = jnp.einsum('bhqd,bhqjd->bhqj', q_blk, k_g)
            s = jnp.where(valid[None, None], s, -jnp.inf)
            lse = jax.nn.logsumexp(s, axis=-1)
            p = jnp.exp(s - lse[..., None])
            outs.append(jnp.einsum('bhqj,bhqjd->bhqd', p, v_g))
            lses.append(lse)
        mix = jax.nn.softmax(jnp.stack(lses), axis=0)
        return jnp.sum(mix[..., None] * jnp.stack(outs), axis=0)

    out = lax.map(block, jnp.arange(seq // Q_BLOCK))
    return out.transpose(1, 2, 0, 3, 4).reshape(b, h, seq, HEAD_DIM).astype(q.dtype)


def stick_breaking_attention(q, k, v):
    b, h, seq, _ = q.shape
    scale = 1.0 / math.sqrt(HEAD_DIM)
    offs = jnp.arange(Q_BLOCK)
    key_pos = jnp.arange(seq)
    kf = k.astype(jnp.float32)
    vf = v.astype(jnp.float32)

    def block(blk):
        t = blk * Q_BLOCK + offs
        q_blk = lax.dynamic_slice_in_dim(q, blk * Q_BLOCK, Q_BLOCK, axis=2).astype(jnp.float32)
        z = jnp.einsum('bhqd,bhkd->bhqk', q_blk, kf) * scale
        causal = key_pos[None, :] < t[:, None]
        log_keep = jnp.where(causal, jax.nn.log_sigmoid(-z), 0.0)
        tail = lax.cumsum(log_keep, axis=3, reverse=True)
        between = jnp.concatenate([tail[..., 1:], jnp.zeros_like(tail[..., :1])], axis=-1)
        weights = jnp.where(causal, jnp.exp(jax.nn.log_sigmoid(z) + between), 0.0)
        return jnp.einsum('bhqk,bhkd->bhqd', weights, vf)

    out = lax.map(block, jnp.arange(seq // Q_BLOCK))
    return out.transpose(1, 2, 0, 3, 4).reshape(b, h, seq, HEAD_DIM).astype(q.dtype)


def _linear_recurrence_combine(left, right):
    a1, b1 = left
    a2, b2 = right
    return a1 * a2, a2 * b1 + b2


def rg_lru_branch(x, conv_w, conv_b, gate_a_w, gate_a_b, gate_x_w, gate_x_b, lru_lambda):
    b, s, w = x.shape
    xc = lax.conv_general_dilated(
        x, conv_w[:, None, :].astype(x.dtype), window_strides=(1,), padding=[(CONV_WIDTH - 1, 0)],
        dimension_numbers=('NWC', 'WIO', 'NWC'), feature_group_count=w) + conv_b
    xg = xc.reshape(b, s, N_LRU_BLOCKS, HEAD_DIM)
    r = jax.nn.sigmoid(jnp.einsum('bsnd,nde->bsne', xg, gate_a_w) + gate_a_b).reshape(b, s, w)
    i = jax.nn.sigmoid(jnp.einsum('bsnd,nde->bsne', xg, gate_x_w) + gate_x_b).reshape(b, s, w)
    log_a = LRU_C * r.astype(jnp.float32) * jax.nn.log_sigmoid(lru_lambda.astype(jnp.float32))
    a = jnp.exp(log_a)
    u = jnp.sqrt(-jnp.expm1(2.0 * log_a)) * (i * xc).astype(jnp.float32)
    _, h = lax.associative_scan(_linear_recurrence_combine, (a, u), axis=1)
    return h.astype(x.dtype)


def hybrid_layer(x, cos, sin, norm_gain, w_in, conv_w, conv_b, gate_a_w, gate_a_b,
                 gate_x_w, gate_x_b, lru_lambda, w_out):
    b, s, _ = x.shape
    hn = rms_norm(x, norm_gain)
    proj = jnp.einsum('bsd,de->bse', hn, w_in)
    a_q, a_k, a_v, a_g, b_x, b_g, c_q, c_k, c_v, c_g = jnp.split(proj, _in_split_points(), axis=-1)

    qa = apply_partial_rope(a_q.reshape(b, s, N_HEADS_DIL, HEAD_DIM), cos, sin).transpose(0, 2, 1, 3)
    ka = apply_partial_rope(a_k.reshape(b, s, N_HEADS_DIL, HEAD_DIM), cos, sin).transpose(0, 2, 1, 3)
    va = a_v.reshape(b, s, N_HEADS_DIL, HEAD_DIM).transpose(0, 2, 1, 3)
    y_a = dilated_attention(qa, ka, va).transpose(0, 2, 1, 3).reshape(b, s, W_DIL) * jax.nn.silu(a_g)

    y_b = rg_lru_branch(b_x, conv_w, conv_b, gate_a_w, gate_a_b, gate_x_w, gate_x_b, lru_lambda) * jax.nn.silu(b_g)

    qc = c_q.reshape(b, s, N_HEADS_SB, HEAD_DIM).transpose(0, 2, 1, 3)
    kc = c_k.reshape(b, s, N_HEADS_SB, HEAD_DIM).transpose(0, 2, 1, 3)
    vc = c_v.reshape(b, s, N_HEADS_SB, HEAD_DIM).transpose(0, 2, 1, 3)
    y_c = stick_breaking_attention(qc, kc, vc).transpose(0, 2, 1, 3).reshape(b, s, W_SB) * jax.nn.silu(c_g)

    y = jnp.concatenate([y_a, y_b, y_c], axis=-1)
    return x + jnp.einsum('bse,ed->bsd', y, w_out)


def setup_inputs(seed: int = 0) -> dict:
    key = jax.random.key(seed)
    ks = jax.random.split(key, 13)
    f32 = jnp.float32
    x = jax.random.normal(ks[0], (BATCH, SEQ, D_MODEL), f32)
    norm_gain = 1.0 + 0.02 * jax.random.normal(ks[1], (DEPTH, D_MODEL), f32)
    w_in = jax.random.normal(ks[2], (DEPTH, D_MODEL, D_IN), f32) * D_MODEL ** -0.5
    conv_w = jax.random.normal(ks[3], (DEPTH, CONV_WIDTH, W_LRU), f32) * CONV_WIDTH ** -0.5
    conv_b = 0.01 * jax.random.normal(ks[4], (DEPTH, W_LRU), f32)
    gate_a_w = jax.random.normal(ks[5], (DEPTH, N_LRU_BLOCKS, HEAD_DIM, HEAD_DIM), f32) * HEAD_DIM ** -0.5
    gate_a_b = 0.01 * jax.random.normal(ks[6], (DEPTH, N_LRU_BLOCKS, HEAD_DIM), f32)
    gate_x_w = jax.random.normal(ks[7], (DEPTH, N_LRU_BLOCKS, HEAD_DIM, HEAD_DIM), f32) * HEAD_DIM ** -0.5
    gate_x_b = 0.01 * jax.random.normal(ks[8], (DEPTH, N_LRU_BLOCKS, HEAD_DIM), f32)
    u = jax.random.uniform(ks[9], (DEPTH, W_LRU), f32, minval=0.9, maxval=0.999)
    a0 = u ** (1.0 / LRU_C)
    lru_lambda = jnp.log(a0) - jnp.log1p(-a0)
    w_out = jax.random.normal(ks[10], (DEPTH, D_MIX, D_MODEL), f32) * D_MIX ** -0.5
    final_gain = 1.0 + 0.02 * jax.random.normal(ks[11], (D_MODEL,), f32)
    return {'x': x, 'norm_gain': norm_gain, 'w_in': w_in, 'conv_w': conv_w, 'conv_b': conv_b,
            'gate_a_w': gate_a_w, 'gate_a_b': gate_a_b, 'gate_x_w': gate_x_w, 'gate_x_b': gate_x_b,
            'lru_lambda': lru_lambda, 'w_out': w_out, 'final_gain': final_gain}


def reference(x, norm_gain, w_in, conv_w, conv_b, gate_a_w, gate_a_b, gate_x_w, gate_x_b,
              lru_lambda, w_out, final_gain):
    cos, sin = rope_tables(x.shape[1])
    h = x
    for l in range(DEPTH):
        h = hybrid_layer(h, cos, sin, norm_gain[l], w_in[l], conv_w[l], conv_b[l], gate_a_w[l],
                         gate_a_b[l], gate_x_w[l], gate_x_b[l], lru_lambda[l], w_out[l])
    return rms_norm(h, final_gain)
```

```cpp
#include <hip/hip_runtime.h>
#include <hip/hip_cooperative_groups.h>
#include <cstdio>
namespace cg = cooperative_groups;

#define DI __device__ __forceinline__
typedef unsigned short bf16_t;
using bf16x8 = __attribute__((ext_vector_type(8))) short;
using f32x16 = __attribute__((ext_vector_type(16))) float;

constexpr int S = 8192, NB = 2, T = NB * S, DM = 1024, DIN = 3584;
constexpr int OFF_AQ = 0, OFF_AK = 512, OFF_AV = 1024, OFF_AG = 1536, OFF_BX = 2048, OFF_BG = 2304,
              OFF_CQ = 2560, OFF_CK = 2816, OFF_CV = 3072, OFF_CG = 3328;
constexpr int LCH = 64;
constexpr int NCH = S / LCH;
constexpr int LDS_BYTES = 3 * 24576 + 1024 + 16;
constexpr int NTHREADS = 256;

struct Params {
  const float *x, *norm_gain, *w_in, *conv_w, *conv_b, *gaw, *gab, *gxw, *gxb, *lam, *w_out, *final_gain;
  float* out;
  bf16_t *winT, *woutT, *proj, *y, *hn, *part_o, *gwT;
  float *aggA, *aggH, *part, *part_l;
  bf16_t *hloc, *cumA;
  float2* rope;
  unsigned* bar;
  int use_cg_sync; int pad_;
};

typedef __bf16 bf16x2_t __attribute__((ext_vector_type(2)));
typedef float f32x2 __attribute__((ext_vector_type(2)));
DI unsigned cvt_pk(float a, float b) { f32x2 v = {a, b}; return __builtin_bit_cast(unsigned, __builtin_convertvector(v, bf16x2_t)); }
DI bf16_t f2bf(float x) { return (bf16_t)(cvt_pk(x, 0.f) & 0xffffu); }
DI float bf2f(bf16_t h) { return __uint_as_float(((unsigned)h) << 16); }
DI unsigned pack2(float a, float b) { return cvt_pk(a, b); }
DI float lo16(unsigned u) { return __uint_as_float(u << 16); }
DI float hi16(unsigned u) { return __uint_as_float(u & 0xffff0000u); }
DI float x32_other(float x, int h) {
  const auto rr = __builtin_amdgcn_permlane32_swap(__float_as_uint(x), __float_as_uint(x), false, false);
  return __uint_as_float(h ? rr[0] : rr[1]);
}
DI float x32_max(float x) { const auto rr = __builtin_amdgcn_permlane32_swap(__float_as_uint(x), __float_as_uint(x), false, false); return fmaxf(__uint_as_float(rr[0]), __uint_as_float(rr[1])); }
DI float x32_sum(float x) { const auto rr = __builtin_amdgcn_permlane32_swap(__float_as_uint(x), __float_as_uint(x), false, false); return __uint_as_float(rr[0]) + __uint_as_float(rr[1]); }
typedef unsigned u32x4n __attribute__((ext_vector_type(4)));
typedef float f32x4n __attribute__((ext_vector_type(4)));
typedef unsigned u32x2n __attribute__((ext_vector_type(2)));
DI uint4 ld_nt16(const void* p) { const u32x4n v = __builtin_nontemporal_load((const u32x4n*)p); return make_uint4(v[0], v[1], v[2], v[3]); }
DI uint2 ld_nt8(const void* p) { const u32x2n v = __builtin_nontemporal_load((const u32x2n*)p); return make_uint2(v[0], v[1]); }
DI float4 ld_nt_f4(const void* p) { const f32x4n v = __builtin_nontemporal_load((const f32x4n*)p); return make_float4(v[0], v[1], v[2], v[3]); }
DI float ld_nt_f(const float* p) { return __builtin_nontemporal_load(p); }
DI bf16_t ld_nt_h(const bf16_t* p) { return __builtin_nontemporal_load(p); }
DI void st_nt16(void* p, float4 v) { f32x4n w = {v.x, v.y, v.z, v.w}; __builtin_nontemporal_store(w, (f32x4n*)p); }
DI void st_pair16(bf16_t* row_base_lane, int k, uint2 a, uint2 b) {
  const auto rx = __builtin_amdgcn_permlane32_swap(a.x, b.x, false, false);
  const auto ry = __builtin_amdgcn_permlane32_swap(a.y, b.y, false, false);
  *(uint4*)(row_base_lane + 8 * k) = make_uint4(rx[0], ry[0], rx[1], ry[1]);
}
DI void ld_pair16(const bf16_t* row_base_lane, int k, uint2& a, uint2& b) {
  const uint4 q = *(const uint4*)(row_base_lane + 8 * k);
  const auto rx = __builtin_amdgcn_permlane32_swap(q.x, q.z, false, false);
  const auto ry = __builtin_amdgcn_permlane32_swap(q.y, q.w, false, false);
  a = make_uint2(rx[0], ry[0]); b = make_uint2(rx[1], ry[1]);
}
DI int opq(int v) { asm volatile("" : "+v"(v)); return v; }
DI float sigmoidf_(float x) { return 1.f / (1.f + __expf(-x)); }
DI float siluf_(float x) { return x * __builtin_amdgcn_rcpf(1.f + __builtin_amdgcn_exp2f(-1.4426950408889634f * x)); }

DI void phase0(const Params& p, unsigned char* smem) {
  const int tid0 = opq(threadIdx.x);
  const int gtid = blockIdx.x * NTHREADS + tid0;
  const int gsz = gridDim.x * NTHREADS;
  const bool rows_first = blockIdx.x >= (gridDim.x >> 1);
#pragma unroll 1
  for (int step = 0; step < 2; ++step) {
  if ((step == 0) != rows_first) {
  {
    bf16_t* tl = (bf16_t*)smem;
    const int tid = tid0;
    for (int task = blockIdx.x; task < 2 * 16 * 56 + 2 * 16 * 16; task += gridDim.x) {
      const bool is_in = task < 2 * 16 * 56;
      const int tt = is_in ? task : task - 2 * 16 * 56;
      const int NBL = is_in ? 56 : 16;
      const int N = is_in ? DIN : DM;
      const int nb = tt % NBL; const int kb = (tt / NBL) & 15; const int l = tt / (NBL * 16);
      const float* src = (is_in ? p.w_in : p.w_out) + (size_t)l * DM * N + (size_t)(kb * 64) * N + nb * 64;
      bf16_t* dst = (is_in ? p.winT : p.woutT) + ((size_t)l * N + nb * 64) * DM + kb * 64;
      __syncthreads();
      const int n4 = tid & 15, k0 = (tid >> 4) * 4;
      float4 tv[4];
#pragma unroll
      for (int r = 0; r < 4; ++r) tv[r] = ld_nt_f4(src + (size_t)(k0 + r) * N + n4 * 4);
      if (is_in) {
        const float4 gk = *(const float4*)(p.norm_gain + l * DM + kb * 64 + k0);
        tv[0].x *= gk.x; tv[0].y *= gk.x; tv[0].z *= gk.x; tv[0].w *= gk.x;
        tv[1].x *= gk.y; tv[1].y *= gk.y; tv[1].z *= gk.y; tv[1].w *= gk.y;
        tv[2].x *= gk.z; tv[2].y *= gk.z; tv[2].z *= gk.z; tv[2].w *= gk.z;
        tv[3].x *= gk.w; tv[3].y *= gk.w; tv[3].z *= gk.w; tv[3].w *= gk.w;
      }
      *(uint2*)(tl + (n4 * 4 + 0) * 72 + k0) = make_uint2(pack2(tv[0].x, tv[1].x), pack2(tv[2].x, tv[3].x));
      *(uint2*)(tl + (n4 * 4 + 1) * 72 + k0) = make_uint2(pack2(tv[0].y, tv[1].y), pack2(tv[2].y, tv[3].y));
      *(uint2*)(tl + (n4 * 4 + 2) * 72 + k0) = make_uint2(pack2(tv[0].z, tv[1].z), pack2(tv[2].z, tv[3].z));
      *(uint2*)(tl + (n4 * 4 + 3) * 72 + k0) = make_uint2(pack2(tv[0].w, tv[1].w), pack2(tv[2].w, tv[3].w));
      __syncthreads();
#pragma unroll
      for (int ps = 0; ps < 2; ++ps) {
        const int idx = tid + 256 * ps; const int n = idx >> 3, kc = idx & 7;
        *(uint4*)(dst + (size_t)n * DM + kc * 8) = *(const uint4*)(tl + n * 72 + kc * 8);
      }
    }
  }
  } else {
  for (int i = gtid; i < 2 * 2 * 4 * 64 * 64; i += gsz) {
    const int d = i & 63, e = (i >> 6) & 63, n = (i >> 12) & 3, gate = (i >> 14) & 1, l = i >> 15;
    const float* src = gate ? p.gxw : p.gaw;
    p.gwT[i] = f2bf(src[(((size_t)l * 4 + n) * 64 + d) * 64 + e]);
  }
  for (int i = gtid; i < S * 8; i += gsz) {
    const int pos = i >> 3, f = i & 7;
    float invf;
    switch (f) {
      case 0: invf = 1.0f; break;
      case 1: invf = 0.19392274474868576f; break;
      case 2: invf = 0.03760603093086393f; break;
      case 3: invf = 0.007292664737217109f; break;
      case 4: invf = 0.001414213562373095f; break;
      case 5: invf = 0.0002742481756762073f; break;
      case 6: invf = 5.318295896944988e-05f; break;
      default: invf = 1.031338537721246e-05f; break;
    }
    const float ang = (float)pos * invf;
    const double a = (double)ang;
    const double k = rint(a * 0.15915494309189535);
    const float r = (float)(a - k * 6.283185307179586);
    p.rope[i] = make_float2(__cosf(r), __sinf(r));
  }
  const int lane = tid0 & 63;
  const int gw = gtid >> 6, nw = gsz >> 6;
  for (int row = gw; row < T; row += 2 * nw) {
    const int row2 = row + nw;
    const bool has2 = row2 < T;
    const float4* xr = (const float4*)(p.x + (size_t)row * DM);
    const float4* xr2 = (const float4*)(p.x + (size_t)(has2 ? row2 : row) * DM);
    float4 v[4], v2[4];
#pragma unroll
    for (int j = 0; j < 4; ++j) { const int f4 = 2 * lane + (j & 1) + 128 * (j >> 1); v[j] = ld_nt_f4(xr + f4); v2[j] = ld_nt_f4(xr2 + f4); }
    float ss = 0.f, ss2 = 0.f;
#pragma unroll
    for (int j = 0; j < 4; ++j) {
      ss += v[j].x * v[j].x + v[j].y * v[j].y + v[j].z * v[j].z + v[j].w * v[j].w;
      ss2 += v2[j].x * v2[j].x + v2[j].y * v2[j].y + v2[j].z * v2[j].z + v2[j].w * v2[j].w;
    }
#pragma unroll
    for (int o = 32; o >= 1; o >>= 1) { ss += __shfl_xor(ss, o); ss2 += __shfl_xor(ss2, o); }
    const float rs = rsqrtf(ss * (1.f / DM) + 1e-6f), rs2 = rsqrtf(ss2 * (1.f / DM) + 1e-6f);
    uint4* hr = (uint4*)(p.hn + (size_t)row * DM);
#pragma unroll
    for (int m = 0; m < 2; ++m)
      hr[lane + 64 * m] = make_uint4(pack2(v[2 * m].x * rs, v[2 * m].y * rs), pack2(v[2 * m].z * rs, v[2 * m].w * rs),
                                     pack2(v[2 * m + 1].x * rs, v[2 * m + 1].y * rs), pack2(v[2 * m + 1].z * rs, v[2 * m + 1].w * rs));
    if (has2) {
      uint4* hr2 = (uint4*)(p.hn + (size_t)row2 * DM);
#pragma unroll
      for (int m = 0; m < 2; ++m)
        hr2[lane + 64 * m] = make_uint4(pack2(v2[2 * m].x * rs2, v2[2 * m].y * rs2), pack2(v2[2 * m].z * rs2, v2[2 * m].w * rs2),
                                        pack2(v2[2 * m + 1].x * rs2, v2[2 * m + 1].y * rs2), pack2(v2[2 * m + 1].z * rs2, v2[2 * m + 1].w * rs2));
    }
  }
  }
  }
}

DI void phaseN(const Params& p) {
  const int tid0 = opq(threadIdx.x);
  const int gtid = blockIdx.x * NTHREADS + tid0;
  const int gsz = gridDim.x * NTHREADS;
  const int lane = tid0 & 63;
  const int gw = gtid >> 6, nw = gsz >> 6;
  for (int row = gw; row < T; row += nw) {
    float ss = (lane < 16) ? p.part[(size_t)row * 16 + lane] : 0.f;
#pragma unroll
    for (int o = 8; o >= 1; o >>= 1) ss += __shfl_xor(ss, o);
    ss = __shfl(ss, 0);
    const float rs = rsqrtf(ss * (1.f / DM) + 1e-6f);
    const float4* xr = (const float4*)(p.out + (size_t)row * DM);
    uint2* hr = (uint2*)(p.hn + (size_t)row * DM);
#pragma unroll
    for (int j = 0; j < 4; ++j) {
      const float4 v = xr[lane + 64 * j];
      hr[lane + 64 * j] = make_uint2(pack2(v.x * rs, v.y * rs), pack2(v.z * rs, v.w * rs));
    }
  }
}

constexpr int LR2 = 40;
constexpr int NKT = DM / 32;
constexpr int GST = 24576;
constexpr int RSTD_OFF = 3 * GST;
constexpr int XBW_OFF = RSTD_OFF + 1024;
#define RAW_BARRIER() do { __builtin_amdgcn_s_waitcnt(0xC07F);   __builtin_amdgcn_s_barrier(); } while (0)
template <int MODE>
DI void gemm_phase(const Params& p, int layer, unsigned char* smem, int vb) {
  float* rstd_s = (float*)(smem + RSTD_OFF);
  const int tid = opq(threadIdx.x), lane = tid & 63, w = tid >> 6;
  const int wr = w >> 1, wc = w & 1;
  const int l31 = lane & 31, lh = lane >> 5;
  constexpr int NCT = (MODE == 0) ? (DIN / 128) : (DM / 128);
  constexpr int NTILES = (T / 256) * NCT;
  const bf16_t* Ab = (MODE == 0) ? p.hn : p.y;
  const bf16_t* Bt = (MODE == 0) ? (p.winT + (size_t)layer * DIN * DM) : (p.woutT + (size_t)layer * DM * DM);
  const int swz = (l31 >> 2) & 3;
  const int c0 = ((lh) ^ swz) * 16, c1 = ((2 + lh) ^ swz) * 16;
  const int aoff = (wr * 128 + l31) * 64, boff = 16384 + (wc * 64 + l31) * 64;

  const bool swzo = (gridDim.x % 8) == 0;
  const int nper = swzo ? (NTILES / 8) : NTILES;
  const int istart = swzo ? (vb >> 3) : vb;
  const int istep = swzo ? (gridDim.x >> 3) : gridDim.x;
  for (int it = istart; it < nper; it += istep) {
    int rt, ct;
    if (swzo) { rt = (vb & 7) * 8 + (it & 7); ct = it >> 3; }
    else { rt = it / NCT; ct = it % NCT; }
    const int row0 = rt * 256, col0 = ct * 128;
    f32x16 acc[4][2];
#pragma unroll
    for (int i = 0; i < 4; ++i)
#pragma unroll
      for (int j = 0; j < 2; ++j)
#pragma unroll
        for (int r = 0; r < 16; ++r) acc[i][j][r] = 0.f;

    const char* gp[6];
#pragma unroll
    for (int i = 0; i < 6; ++i) {
      const int q = w * 6 + i;
      const int trow = ((q < 16) ? q : (q - 16)) * 16 + (lane >> 2);
      const int chunk = (lane & 3) ^ ((trow >> 2) & 3);
      const bf16_t* src = (q < 16) ? (Ab + (size_t)(row0 + trow) * DM) : (Bt + (size_t)(col0 + trow) * DM);
      gp[i] = (const char*)(src + chunk * 8);
    }
#define GLDS(KT, ST) do { _Pragma("unroll") for (int i_ = 0; i_ < 6; ++i_) \
      __builtin_amdgcn_global_load_lds((const unsigned*)(gp[i_] + (KT) * 64), (unsigned*)(smem + (ST) * GST + (w * 6 + i_) * 1024), 16, 0, 0); } while (0)
    bf16x8 fa0, fa1, fa2, fa3, fb0, fb1, ga0, ga1, ga2, ga3, gb0, gb1;
#define READS0(ST) do { const unsigned char* sb_ = smem + (ST) * GST; \
      fb0 = *(const bf16x8*)(sb_ + boff + c0); fb1 = *(const bf16x8*)(sb_ + boff + 2048 + c0); \
      fa0 = *(const bf16x8*)(sb_ + aoff + c0); fa1 = *(const bf16x8*)(sb_ + aoff + 2048 + c0); fa2 = *(const bf16x8*)(sb_ + aoff + 4096 + c0); fa3 = *(const bf16x8*)(sb_ + aoff + 6144 + c0); } while (0)
#define READS1(ST) do { const unsigned char* sb_ = smem + (ST) * GST; \
      gb0 = *(const bf16x8*)(sb_ + boff + c1); gb1 = *(const bf16x8*)(sb_ + boff + 2048 + c1); \
      ga0 = *(const bf16x8*)(sb_ + aoff + c1); ga1 = *(const bf16x8*)(sb_ + aoff + 2048 + c1); ga2 = *(const bf16x8*)(sb_ + aoff + 4096 + c1); ga3 = *(const bf16x8*)(sb_ + aoff + 6144 + c1); } while (0)
#define MM(AF, BF, I, J) acc[I][J] = __builtin_amdgcn_mfma_f32_32x32x16_bf16(BF, AF, acc[I][J], 0, 0, 0)
#define MFMA0() do { MM(fa0, fb0, 0, 0); MM(fa0, fb1, 0, 1); MM(fa1, fb0, 1, 0); MM(fa1, fb1, 1, 1); MM(fa2, fb0, 2, 0); MM(fa2, fb1, 2, 1); MM(fa3, fb0, 3, 0); MM(fa3, fb1, 3, 1); } while (0)
#define MFMA1() do { MM(ga0, gb0, 0, 0); MM(ga0, gb1, 0, 1); MM(ga1, gb0, 1, 0); MM(ga1, gb1, 1, 1); MM(ga2, gb0, 2, 0); MM(ga2, gb1, 2, 1); MM(ga3, gb0, 3, 0); MM(ga3, gb1, 3, 1); } while (0)
    RAW_BARRIER();
    float4 qa_ = make_float4(0.f, 0.f, 0.f, 0.f), qb_ = qa_, qc_ = qa_, qd_ = qa_;
    if (MODE == 0 && layer > 0) {
      const float4* pp = (const float4*)(p.part + (size_t)(row0 + tid) * 16);
      qa_ = pp[0]; qb_ = pp[1]; qc_ = pp[2]; qd_ = pp[3];
    }
    GLDS(0, 0);
    GLDS(1, 1);
    if (MODE == 0 && layer > 0) {
      const float ss = qa_.x + qa_.y + qa_.z + qa_.w + qb_.x + qb_.y + qb_.z + qb_.w + qc_.x + qc_.y + qc_.z + qc_.w + qd_.x + qd_.y + qd_.z + qd_.w;
      rstd_s[tid] = rsqrtf(ss * (1.f / DM) + 1e-6f);
    }
    float pf0 = 0.f, pf1 = 0.f, pf2 = 0.f, pf3 = 0.f;
    if (MODE == 1 && layer == 0) {
      const float* xb = p.x + (size_t)(row0 + wr * 128 + l31) * DM + col0 + wc * 64 + lh * 32;
      pf0 = xb[0]; pf1 = xb[(size_t)32 * DM]; pf2 = xb[(size_t)64 * DM]; pf3 = xb[(size_t)96 * DM];
    }
    asm volatile("s_waitcnt vmcnt(6)" ::: "memory");
    RAW_BARRIER();
    GLDS(2, 2);
    READS0(0);
    MFMA0();
    READS1(0);
    __builtin_amdgcn_sched_barrier(0);
    int st = 1;
#pragma unroll 1
    for (int kt = 1; kt < NKT - 1; ++kt) {
      asm volatile("s_waitcnt vmcnt(6)" ::: "memory");
      RAW_BARRIER();
      const int stn = (st == 0) ? 2 : (st - 1);
      GLDS((kt + 2 < NKT) ? (kt + 2) : (NKT - 1), stn);
      __builtin_amdgcn_s_setprio(1);
      READS0(st);
      MFMA1();
      MFMA0();
      READS1(st);
      __builtin_amdgcn_sched_group_barrier(0x100, 6, 0);
      __builtin_amdgcn_sched_group_barrier(0x008, 10, 0);
      __builtin_amdgcn_sched_group_barrier(0x100, 6, 0);
      __builtin_amdgcn_sched_group_barrier(0x008, 6, 0);
      __builtin_amdgcn_s_setprio(0);
      __builtin_amdgcn_sched_barrier(0);
      st = (st == 2) ? 0 : (st + 1);
    }
    asm volatile("s_waitcnt vmcnt(0)" ::: "memory");
    RAW_BARRIER();
    READS0(st);
    MFMA1();
    MFMA0();
    READS1(st);
    __builtin_amdgcn_sched_group_barrier(0x100, 6, 0);
    __builtin_amdgcn_sched_group_barrier(0x008, 10, 0);
    __builtin_amdgcn_sched_group_barrier(0x100, 6, 0);
    __builtin_amdgcn_sched_group_barrier(0x008, 6, 0);
    __builtin_amdgcn_sched_barrier(0);
    MFMA1();
    asm volatile("" :: "v"(pf0), "v"(pf1), "v"(pf2), "v"(pf3));
    if (MODE == 0) {
      const int gcolw = col0 + wc * 64;
      const bool do_rope = gcolw < 1024;
      const bool qscale = (gcolw < 512) || (gcolw >= OFF_CQ && gcolw < OFF_CK);
#pragma unroll
      for (int i = 0; i < 4; ++i) {
        const int lrw = wr * 128 + i * 32 + l31;
        const int grow = row0 + lrw;
        float sc = qscale ? 0.18033688011112042f : 1.f;
        if (layer > 0) sc *= rstd_s[lrw];
        bf16_t* dstp = p.proj + (size_t)grow * DIN + gcolw + 8 * lh;
        uint2 og[2][4];
#pragma unroll
        for (int j = 0; j < 2; ++j)
#pragma unroll
          for (int g = 0; g < 4; ++g) {
            og[j][g].x = pack2(acc[i][j][4 * g + 0] * sc, acc[i][j][4 * g + 1] * sc);
            og[j][g].y = pack2(acc[i][j][4 * g + 2] * sc, acc[i][j][4 * g + 3] * sc);
          }
        if (do_rope) {
          const float4* tab = (const float4*)(p.rope + (size_t)(grow & (S - 1)) * 8 + 4 * lh);
          const float4 cs01 = tab[0], cs23 = tab[1];
          const float c0r = cs01.x, s0r = cs01.y, c1r = cs01.z, s1r = cs01.w, c2r = cs23.x, s2r = cs23.y, c3r = cs23.z, s3r = cs23.w;
          const float x10 = acc[i][0][0] * sc, x11 = acc[i][0][1] * sc, x12 = acc[i][0][2] * sc, x13 = acc[i][0][3] * sc;
          const float x20 = acc[i][0][4] * sc, x21 = acc[i][0][5] * sc, x22 = acc[i][0][6] * sc, x23 = acc[i][0][7] * sc;
          og[0][0].x = pack2(x10 * c0r - x20 * s0r, x11 * c1r - x21 * s1r); og[0][0].y = pack2(x12 * c2r - x22 * s2r, x13 * c3r - x23 * s3r);
          og[0][1].x = pack2(x20 * c0r + x10 * s0r, x21 * c1r + x11 * s1r); og[0][1].y = pack2(x22 * c2r + x12 * s2r, x23 * c3r + x13 * s3r);
        }
#pragma unroll
        for (int j = 0; j < 2; ++j) {
          st_pair16(dstp + j * 32, 0, og[j][0], og[j][1]);
          st_pair16(dstp + j * 32, 2, og[j][2], og[j][3]);
        }
        __builtin_amdgcn_sched_barrier(0);
      }
    } else {
#pragma unroll
      for (int i = 0; i < 4; ++i) {
        const int lrw = wr * 128 + i * 32 + l31;
        const int grow = row0 + lrw;
        const size_t ob = (size_t)grow * DM + col0 + wc * 64 + 4 * lh;
        float ss = 0.f;
        bf16_t* hrow = p.hn + (size_t)grow * DM + col0 + wc * 64 + 8 * lh;
#pragma unroll
        for (int j = 0; j < 2; ++j) {
          uint2 og[4];
          uint2 hbv[4] = {make_uint2(0u, 0u), make_uint2(0u, 0u), make_uint2(0u, 0u), make_uint2(0u, 0u)};
          if (layer != 0) { ld_pair16(hrow + j * 32, 0, hbv[0], hbv[1]); ld_pair16(hrow + j * 32, 2, hbv[2], hbv[3]); }
#pragma unroll
          for (int g = 0; g < 4; ++g) {
            const size_t o = ob + j * 32 + 8 * g;
            float4 rv;
            if (layer == 0) rv = *(const float4*)(p.x + o);
            else { const uint2 hb = hbv[g]; rv = make_float4(lo16(hb.x), hi16(hb.x), lo16(hb.y), hi16(hb.y)); }
            float4 v;
            v.x = acc[i][j][4 * g + 0] + rv.x; v.y = acc[i][j][4 * g + 1] + rv.y; v.z = acc[i][j][4 * g + 2] + rv.z; v.w = acc[i][j][4 * g + 3] + rv.w;
            og[g] = make_uint2(pack2(v.x, v.y), pack2(v.z, v.w));
            ss += v.x * v.x + v.y * v.y + v.z * v.z + v.w * v.w;
          }
          st_pair16(hrow + j * 32, 0, og[0], og[1]);
          st_pair16(hrow + j * 32, 2, og[2], og[3]);
        }
        ss = x32_sum(ss);
        if (lh == 0) p.part[(size_t)grow * 16 + ct * 2 + wc] = ss;
        __builtin_amdgcn_sched_barrier(0);
      }
    }
  }
}

typedef short s16x4 __attribute__((ext_vector_type(4)));
typedef unsigned u32x4 __attribute__((ext_vector_type(4)));
constexpr int VROW = 72;
constexpr int VLDS_WAVE = 32 * VROW;

DI bf16x8 pack8f(float a0, float a1, float a2, float a3, float a4, float a5, float a6, float a7) {
  u32x4 r = {cvt_pk(a0, a1), cvt_pk(a2, a3), cvt_pk(a4, a5), cvt_pk(a6, a7)};
  return __builtin_bit_cast(bf16x8, r);
}
DI s16x4 tr_read(const bf16_t* lds_ptr) {
  return __builtin_amdgcn_ds_read_tr16_b64_v4i16((__attribute__((address_space(3))) s16x4*)(lds_ptr));
}
DI bf16x8 vt_frag(const bf16_t* vlds, int lane, int dt, int s) {
  const int h = lane >> 5, blk = (lane >> 4) & 1, qq = (lane & 15) >> 2, pp = lane & 3;
  const bf16_t* a = vlds + (16 * s + 4 * h + qq) * VROW + 32 * dt + 16 * blk + 4 * pp;
  const s16x4 lo = tr_read(a);
  const s16x4 hi = tr_read(a + 8 * VROW);
  return __builtin_shufflevector(lo, hi, 0, 1, 2, 3, 4, 5, 6, 7);
}
struct VRegs { uint4 v0, v1, v2, v3; };
DI VRegs load_v(const bf16_t* src0, size_t row_stride, int lane) {
  const bf16_t* src = src0 + (size_t)(lane >> 3) * row_stride + (lane & 7) * 8;
  VRegs r;
  r.v0 = *(const uint4*)(src);
  r.v1 = *(const uint4*)(src + 8 * row_stride);
  r.v2 = *(const uint4*)(src + 16 * row_stride);
  r.v3 = *(const uint4*)(src + 24 * row_stride);
  return r;
}
DI void store_v(bf16_t* vlds, const VRegs& r, int lane) {
  bf16_t* dst = vlds + (lane >> 3) * VROW + (lane & 7) * 8;
  *(uint4*)(dst) = r.v0; *(uint4*)(dst + 8 * VROW) = r.v1; *(uint4*)(dst + 16 * VROW) = r.v2; *(uint4*)(dst + 24 * VROW) = r.v3;
}
struct KRegs { bf16x8 k0, k1, k2, k3; };
DI KRegs load_k(const bf16_t* rowptr) {
  KRegs r;
  r.k0 = *(const bf16x8*)(rowptr); r.k1 = *(const bf16x8*)(rowptr + 16); r.k2 = *(const bf16x8*)(rowptr + 32); r.k3 = *(const bf16x8*)(rowptr + 48);
  return r;
}

DI void sb_wave_item(const Params& p, int witem, bf16_t* vlds, int lane) {
  const int l31 = lane & 31, h = lane >> 5;
  const int qt = 255 - (witem & 255); const int hh = (witem >> 8) & 3; const int b = witem >> 10;
  const bf16_t* base = p.proj + (size_t)b * S * DIN;
  const int t = qt * 32 + l31;
  bf16x8 qf[4];
#pragma unroll
  for (int ks = 0; ks < 4; ++ks) qf[ks] = *(const bf16x8*)(base + (size_t)t * DIN + OFF_CQ + hh * 64 + ks * 16 + h * 8);
  f32x16 o0, o1;
#pragma unroll
  for (int r = 0; r < 16; ++r) { o0[r] = 0.f; o1[r] = 0.f; }
  float carry = 0.f;
  const bf16_t* kbase = base + (size_t)l31 * DIN + OFF_CK + hh * 64 + h * 8;
  const bf16_t* vbase = base + OFF_CV + hh * 64;
  KRegs kc = load_k(kbase + (size_t)(qt * 32) * DIN);
  VRegs vc = load_v(vbase + (size_t)(qt * 32) * DIN, DIN, lane);
  for (int kt = qt; kt >= 0; --kt) {
    store_v(vlds, vc, lane);
    const KRegs kcur = kc;
    __builtin_amdgcn_sched_barrier(0);
    {
      const int ktn = (kt > 0) ? (kt - 1) : 0;
      kc = load_k(kbase + (size_t)(ktn * 32) * DIN);
      vc = load_v(vbase + (size_t)(ktn * 32) * DIN, DIN, lane);
    }
    __builtin_amdgcn_sched_barrier(0);
    f32x16 sacc;
#pragma unroll
    for (int r = 0; r < 16; ++r) sacc[r] = 0.f;
    sacc = __builtin_amdgcn_mfma_f32_32x32x16_bf16(kcur.k0, qf[0], sacc, 0, 0, 0);
    sacc = __builtin_amdgcn_mfma_f32_32x32x16_bf16(kcur.k1, qf[1], sacc, 0, 0, 0);
    sacc = __builtin_amdgcn_mfma_f32_32x32x16_bf16(kcur.k2, qf[2], sacc, 0, 0, 0);
    sacc = __builtin_amdgcn_mfma_f32_32x32x16_bf16(kcur.k3, qf[3], sacc, 0, 0, 0);
    const bool diag = (kt == qt);
    float lk[16], zs[16];
#pragma unroll
    for (int r = 0; r < 16; ++r) {
      const float z = sacc[r];
      const float e = __builtin_amdgcn_exp2f(-fabsf(z));
      const float sp = fmaxf(z, 0.f) + __builtin_amdgcn_logf(1.f + e);
      const bool valid = !diag || ((8 * (r >> 2) + 4 * h + (r & 3)) < l31);
      lk[r] = valid ? -sp : 0.f;
      zs[r] = valid ? (z - sp) : -INFINITY;
    }
    float Gt[4], Pt[4], ex[16];
#pragma unroll
    for (int g = 0; g < 4; ++g) {
      ex[4 * g + 3] = 0.f;
      ex[4 * g + 2] = lk[4 * g + 3];
      ex[4 * g + 1] = ex[4 * g + 2] + lk[4 * g + 2];
      ex[4 * g + 0] = ex[4 * g + 1] + lk[4 * g + 1];
      Gt[g] = ex[4 * g + 0] + lk[4 * g + 0];
      Pt[g] = x32_other(Gt[g], h);
    }
    const float T0 = Gt[0] + Pt[0], T1 = Gt[1] + Pt[1], T2 = Gt[2] + Pt[2], T3 = Gt[3] + Pt[3];
    float U[4];
    U[3] = 0.f; U[2] = T3; U[1] = U[2] + T2; U[0] = U[1] + T1;
    float w[16];
#pragma unroll
    for (int g = 0; g < 4; ++g) {
      const float after = carry + U[g] + (h == 0 ? Pt[g] : 0.f);
#pragma unroll
      for (int i = 0; i < 4; ++i) w[4 * g + i] = __builtin_amdgcn_exp2f(zs[4 * g + i] + (after + ex[4 * g + i]));
    }
    carry += U[0] + T0;
    const bf16x8 pf0 = pack8f(w[0], w[1], w[2], w[3], w[4], w[5], w[6], w[7]);
    const bf16x8 pf1 = pack8f(w[8], w[9], w[10], w[11], w[12], w[13], w[14], w[15]);
    o0 = __builtin_amdgcn_mfma_f32_32x32x16_bf16(vt_frag(vlds, lane, 0, 0), pf0, o0, 0, 0, 0);
    o1 = __builtin_amdgcn_mfma_f32_32x32x16_bf16(vt_frag(vlds, lane, 1, 0), pf0, o1, 0, 0, 0);
    o0 = __builtin_amdgcn_mfma_f32_32x32x16_bf16(vt_frag(vlds, lane, 0, 1), pf1, o0, 0, 0, 0);
    o1 = __builtin_amdgcn_mfma_f32_32x32x16_bf16(vt_frag(vlds, lane, 1, 1), pf1, o1, 0, 0, 0);
    if (__ballot(carry >= -152.f) == 0ull) break;
  }
  const bf16_t* grow = base + (size_t)t * DIN + OFF_CG + hh * 64;
  bf16_t* yrow = p.y + ((size_t)b * S + t) * DM + 768 + hh * 64 + 8 * h;
  uint2 r0[4], r1[4];
#pragma unroll
  for (int g = 0; g < 4; ++g) {
    const int d0 = 8 * g + 4 * h;
    const uint2 g0 = *(const uint2*)(grow + d0);
    const uint2 g1 = *(const uint2*)(grow + 32 + d0);
    r0[g].x = cvt_pk(o0[4 * g + 0] * siluf_(lo16(g0.x)), o0[4 * g + 1] * siluf_(hi16(g0.x)));
    r0[g].y = cvt_pk(o0[4 * g + 2] * siluf_(lo16(g0.y)), o0[4 * g + 3] * siluf_(hi16(g0.y)));
    r1[g].x = cvt_pk(o1[4 * g + 0] * siluf_(lo16(g1.x)), o1[4 * g + 1] * siluf_(hi16(g1.x)));
    r1[g].y = cvt_pk(o1[4 * g + 2] * siluf_(lo16(g1.y)), o1[4 * g + 3] * siluf_(hi16(g1.y)));
  }
  st_pair16(yrow, 0, r0[0], r0[1]); st_pair16(yrow, 2, r0[2], r0[3]);
  st_pair16(yrow + 32, 0, r1[0], r1[1]); st_pair16(yrow + 32, 2, r1[2], r1[3]);
}

template <bool MASK>
DI void dil_softmax_step(const f32x16& sacc, int dt32, int l31, int h, float& m, float& lsum, f32x16& o0, f32x16& o1, bf16x8& pf0, bf16x8& pf1) {
  const int base = dt32 + l31 - 4 * h;
  float mt = -1e30f;
#pragma unroll
  for (int r = 0; r < 16; ++r) {
    const bool valid = !MASK || ((unsigned)(base - ((r & 3) + 8 * (r >> 2))) <= 128u);
    mt = fmaxf(mt, valid ? sacc[r] : -1e30f);
  }
  mt = x32_max(mt);
  const float mn = fmaxf(m, mt);
  const float corr = __builtin_amdgcn_exp2f(m - mn);
  m = mn;
  float ps = 0.f;
  float w[16];
#pragma unroll
  for (int r = 0; r < 16; ++r) {
    const bool valid = !MASK || ((unsigned)(base - ((r & 3) + 8 * (r >> 2))) <= 128u);
    w[r] = valid ? __builtin_amdgcn_exp2f(sacc[r] - mn) : 0.f;
    ps += w[r];
  }
  lsum = lsum * corr + ps;
#pragma unroll
  for (int r = 0; r < 16; ++r) { o0[r] *= corr; o1[r] *= corr; }
  pf0 = pack8f(w[0], w[1], w[2], w[3], w[4], w[5], w[6], w[7]);
  pf1 = pack8f(w[8], w[9], w[10], w[11], w[12], w[13], w[14], w[15]);
}
DI void dil_write_out(const Params& p, int pat, size_t tok, int hh, int h, float m, float lsum, const f32x16& o0, const f32x16& o1) {
  const float ltot = x32_sum(lsum);
  const float inv = 1.f / ltot;
  if (h == 0) p.part_l[((size_t)pat * T + tok) * 8 + hh] = m + __builtin_amdgcn_logf(ltot);
  bf16_t* orow = p.part_o + ((size_t)pat * T + tok) * 512 + hh * 64 + 8 * h;
  uint2 r0[4], r1[4];
#pragma unroll
  for (int g = 0; g < 4; ++g) {
    r0[g].x = cvt_pk(o0[4 * g + 0] * inv, o0[4 * g + 1] * inv);
    r0[g].y = cvt_pk(o0[4 * g + 2] * inv, o0[4 * g + 3] * inv);
    r1[g].x = cvt_pk(o1[4 * g + 0] * inv, o1[4 * g + 1] * inv);
    r1[g].y = cvt_pk(o1[4 * g + 2] * inv, o1[4 * g + 3] * inv);
  }
  st_pair16(orow, 0, r0[0], r0[1]); st_pair16(orow, 2, r0[2], r0[3]);
  st_pair16(orow + 32, 0, r1[0], r1[1]); st_pair16(orow + 32, 2, r1[2], r1[3]);
}
DI void dil_pair_item(const Params& p, int witem, bf16_t* vlds, int lane) {
  const int l31 = lane & 31, h = lane >> 5;
  const int idx = witem & 127; int rest = witem >> 7; const int pat = rest % 3; rest /= 3; const int hh = rest & 7; const int b = rest >> 3;
  const int dsh = 2 * pat, dil = 1 << dsh;
  const int res = idx & (dil - 1), jt0 = (idx >> dsh) * 2;
  const bf16_t* base = p.proj + (size_t)b * S * DIN;
  const int ta = res + dil * (jt0 * 32 + l31);
  const int tb = ta + dil * 32;
  bf16x8 qa[4], qb[4];
#pragma unroll
  for (int ks = 0; ks < 4; ++ks) {
    qa[ks] = *(const bf16x8*)(base + (size_t)ta * DIN + OFF_AQ + hh * 64 + ks * 16 + h * 8);
    qb[ks] = *(const bf16x8*)(base + (size_t)tb * DIN + OFF_AQ + hh * 64 + ks * 16 + h * 8);
  }
  f32x16 oa0, oa1, ob0, ob1;
#pragma unroll
  for (int r = 0; r < 16; ++r) { oa0[r] = 0.f; oa1[r] = 0.f; ob0[r] = 0.f; ob1[r] = 0.f; }
  float ma = -1e30f, la = 0.f, mb = -1e30f, lb = 0.f;
  const int kt_lo = (jt0 - 4 > 0) ? (jt0 - 4) : 0;
  const int kt_hi = jt0 + 1;
  const bf16_t* kbase = base + (size_t)(res + dil * l31) * DIN + OFF_AK + hh * 64 + h * 8;
  const bf16_t* vbase = base + (size_t)res * DIN + OFF_AV + hh * 64;
  const size_t tstride = (size_t)dil * 32 * DIN;
  KRegs kc = load_k(kbase + (size_t)kt_lo * tstride);
  VRegs vc = load_v(vbase + (size_t)kt_lo * tstride, (size_t)dil * DIN, lane);
  for (int kt = kt_lo; kt <= kt_hi; ++kt) {
    store_v(vlds, vc, lane);
    const KRegs kcur = kc;
    __builtin_amdgcn_sched_barrier(0);
    {
      const int ktn = (kt < kt_hi) ? (kt + 1) : kt_hi;
      kc = load_k(kbase + (size_t)ktn * tstride);
      vc = load_v(vbase + (size_t)ktn * tstride, (size_t)dil * DIN, lane);
    }
    __builtin_amdgcn_sched_barrier(0);
    f32x16 sa, sb;
#pragma unroll
    for (int r = 0; r < 16; ++r) { sa[r] = 0.f; sb[r] = 0.f; }
    sa = __builtin_amdgcn_mfma_f32_32x32x16_bf16(kcur.k0, qa[0], sa, 0, 0, 0);
    sb = __builtin_amdgcn_mfma_f32_32x32x16_bf16(kcur.k0, qb[0], sb, 0, 0, 0);
    sa = __builtin_amdgcn_mfma_f32_32x32x16_bf16(kcur.k1, qa[1], sa, 0, 0, 0);
    sb = __builtin_amdgcn_mfma_f32_32x32x16_bf16(kcur.k1, qb[1], sb, 0, 0, 0);
    sa = __builtin_amdgcn_mfma_f32_32x32x16_bf16(kcur.k2, qa[2], sa, 0, 0, 0);
    sb = __builtin_amdgcn_mfma_f32_32x32x16_bf16(kcur.k2, qb[2], sb, 0, 0, 0);
    sa = __builtin_amdgcn_mfma_f32_32x32x16_bf16(kcur.k3, qa[3], sa, 0, 0, 0);
    sb = __builtin_amdgcn_mfma_f32_32x32x16_bf16(kcur.k3, qb[3], sb, 0, 0, 0);
    const int da = jt0 - kt, db = da + 1;
    const bf16x8 v00 = vt_frag(vlds, lane, 0, 0), v10 = vt_frag(vlds, lane, 1, 0);
    const bf16x8 v01 = vt_frag(vlds, lane, 0, 1), v11 = vt_frag(vlds, lane, 1, 1);
    if (da >= 0) {
      bf16x8 pa0, pa1;
      if (da >= 1 && da <= 3) dil_softmax_step<false>(sa, da * 32, l31, h, ma, la, oa0, oa1, pa0, pa1);
      else dil_softmax_step<true>(sa, da * 32, l31, h, ma, la, oa0, oa1, pa0, pa1);
      oa0 = __builtin_amdgcn_mfma_f32_32x32x16_bf16(v00, pa0, oa0, 0, 0, 0);
      oa1 = __builtin_amdgcn_mfma_f32_32x32x16_bf16(v10, pa0, oa1, 0, 0, 0);
      oa0 = __builtin_amdgcn_mfma_f32_32x32x16_bf16(v01, pa1, oa0, 0, 0, 0);
      oa1 = __builtin_amdgcn_mfma_f32_32x32x16_bf16(v11, pa1, oa1, 0, 0, 0);
    }
    if (db <= 4) {
      bf16x8 pb0, pb1;
      if (db >= 1 && db <= 3) dil_softmax_step<false>(sb, db * 32, l31, h, mb, lb, ob0, ob1, pb0, pb1);
      else dil_softmax_step<true>(sb, db * 32, l31, h, mb, lb, ob0, ob1, pb0, pb1);
      ob0 = __builtin_amdgcn_mfma_f32_32x32x16_bf16(v00, pb0, ob0, 0, 0, 0);
      ob1 = __builtin_amdgcn_mfma_f32_32x32x16_bf16(v10, pb0, ob1, 0, 0, 0);
      ob0 = __builtin_amdgcn_mfma_f32_32x32x16_bf16(v01, pb1, ob0, 0, 0, 0);
      ob1 = __builtin_amdgcn_mfma_f32_32x32x16_bf16(v11, pb1, ob1, 0, 0, 0);
    }
  }
  dil_write_out(p, pat, (size_t)b * S + ta, hh, h, ma, la, oa0, oa1);
  dil_write_out(p, pat, (size_t)b * S + tb, hh, h, mb, lb, ob0, ob1);
}

DI void lru_local_item(const Params& p, int layer, int item, unsigned char* smem) {
  bf16_t* xs = (bf16_t*)smem;
  bf16_t* xcb = xs + 67 * 72;
  float* xcf = (float*)(xcb + 64 * 72);
  float* a_s = xcf + 64 * 65;
  float* u_s = a_s + 64 * 64;
  const int n = item & 3; const int c = (item >> 2) & (NCH - 1); const int b = item >> 9;
  const int tid = opq(threadIdx.x); const int e = tid & 63; const int tq = tid >> 6;
  const int lane = tid & 63, l31 = lane & 31, h = lane >> 5, w = tid >> 6;
  const int ch = n * 64 + e;
  const int t0 = c * LCH;
  const bf16_t* base = p.proj + (size_t)b * S * DIN + OFF_BX + n * 64;
  __syncthreads();
  for (int ci = tid; ci < 67 * 8; ci += NTHREADS) {
    const int r = ci >> 3, c8 = ci & 7; const int t = t0 - 3 + r;
    uint4 v = make_uint4(0u, 0u, 0u, 0u);
    if (t >= 0) v = *(const uint4*)(base + (size_t)t * DIN + c8 * 8);
    *(uint4*)(xs + r * 72 + c8 * 8) = v;
  }
  const float* cw = p.conv_w + layer * 4 * 256;
  const float w0 = cw[0 * 256 + ch], w1 = cw[1 * 256 + ch], w2 = cw[2 * 256 + ch], w3 = cw[3 * 256 + ch];
  const float cb = p.conv_b[layer * 256 + ch];
  __syncthreads();
#pragma unroll
  for (int j = 0; j < 16; ++j) {
    const int tt = tq + 4 * j;
    const float acc = cb + w0 * bf2f(xs[tt * 72 + e]) + w1 * bf2f(xs[(tt + 1) * 72 + e]) + w2 * bf2f(xs[(tt + 2) * 72 + e]) + w3 * bf2f(xs[(tt + 3) * 72 + e]);
    xcf[tt * 65 + e] = acc;
    xcb[tt * 72 + e] = f2bf(acc);
  }
  __syncthreads();
  {
    const int qi = w >> 1, qj = w & 1;
    const bf16_t* wa = p.gwT + (((size_t)(layer * 2 + 0) * 4 + n) * 64 + 32 * qj + l31) * 64 + 8 * h;
    const bf16_t* wx = p.gwT + (((size_t)(layer * 2 + 1) * 4 + n) * 64 + 32 * qj + l31) * 64 + 8 * h;
    f32x16 acc_a, acc_x;
#pragma unroll
    for (int r = 0; r < 16; ++r) { acc_a[r] = 0.f; acc_x[r] = 0.f; }
#pragma unroll
    for (int ks = 0; ks < 4; ++ks) {
      const bf16x8 af = *(const bf16x8*)(xcb + (32 * qi + l31) * 72 + 16 * ks + 8 * h);
      const bf16x8 ba = *(const bf16x8*)(wa + 16 * ks);
      const bf16x8 bx = *(const bf16x8*)(wx + 16 * ks);
      acc_a = __builtin_amdgcn_mfma_f32_32x32x16_bf16(af, ba, acc_a, 0, 0, 0);
      acc_x = __builtin_amdgcn_mfma_f32_32x32x16_bf16(af, bx, acc_x, 0, 0, 0);
    }
    const int ee = 32 * qj + l31; const int che = n * 64 + ee;
    const float ba_ = p.gab[layer * 256 + che], bx_ = p.gxb[layer * 256 + che];
    const float lam = p.lam[layer * 256 + che];
    const float el = __builtin_amdgcn_exp2f(-1.4426950408889634f * fabsf(lam));
    const float l1p = (el < 0.03f) ? el * (1.f - el * (0.5f - el * (0.33333334f - el * 0.25f))) : 0.6931471805599453f * __builtin_amdgcn_logf(1.f + el);
    const float lsl = fminf(lam, 0.f) - l1p;
#pragma unroll
    for (int r = 0; r < 16; ++r) {
      const int tt = 32 * qi + (r & 3) + 8 * (r >> 2) + 4 * h;
      const float rg = __builtin_amdgcn_rcpf(1.f + __builtin_amdgcn_exp2f(-1.4426950408889634f * (acc_a[r] + ba_)));
      const float ig = __builtin_amdgcn_rcpf(1.f + __builtin_amdgcn_exp2f(-1.4426950408889634f * (acc_x[r] + bx_)));
      const float log_a = 8.f * rg * lsl;
      const float a = __builtin_amdgcn_exp2f(1.4426950408889634f * log_a);
      const float x2 = 2.f * log_a;
      const float om_series = -x2 * (1.f + x2 * (0.5f + x2 * (0.16666667f + x2 * (0.041666668f + x2 * 0.008333334f))));
      const float om = (x2 > -0.125f) ? om_series : (1.f - a * a);
      const float u = __builtin_amdgcn_sqrtf(om) * (ig * xcf[tt * 65 + ee]);
      a_s[tt * 64 + ee] = a; u_s[tt * 64 + ee] = u;
    }
  }
  __syncthreads();
  bf16_t* hs = xs;
  bf16_t* cs = xcb;
  {
    float* segA = xcf;
    float* segH = xcf + 256;
    const int sg = tq;
    float av[16], uv[16];
#pragma unroll
    for (int k = 0; k < 16; ++k) { av[k] = a_s[(sg * 16 + k) * 64 + e]; uv[k] = u_s[(sg * 16 + k) * 64 + e]; }
    float A = 1.f, H = 0.f;
#pragma unroll
    for (int k = 0; k < 16; ++k) { H = av[k] * H + uv[k]; A *= av[k]; }
    segA[sg * 64 + e] = A; segH[sg * 64 + e] = H;
    __syncthreads();
    float hh = 0.f, Ac = 1.f;
    for (int s2 = 0; s2 < sg; ++s2) { const float sa = segA[s2 * 64 + e]; hh = sa * hh + segH[s2 * 64 + e]; Ac *= sa; }
#pragma unroll
    for (int k = 0; k < 16; ++k) {
      hh = av[k] * hh + uv[k]; Ac *= av[k];
      hs[(sg * 16 + k) * 64 + e] = f2bf(hh); cs[(sg * 16 + k) * 64 + e] = f2bf(Ac);
    }
    if (sg == 3) {
      p.aggA[((size_t)b * NCH + c) * 256 + ch] = Ac;
      p.aggH[((size_t)b * NCH + c) * 256 + ch] = hh;
    }
  }
  __syncthreads();
#pragma unroll
  for (int k = 0; k < 2; ++k) {
    const int ci = tid + k * NTHREADS; const int tt = ci >> 3, c8 = ci & 7;
    const size_t o = ((size_t)b * S + t0 + tt) * 256 + n * 64 + c8 * 8;
    *(uint4*)(p.hloc + o) = *(const uint4*)(hs + tt * 64 + c8 * 8);
    *(uint4*)(p.cumA + o) = *(const uint4*)(cs + tt * 64 + c8 * 8);
  }
  __syncthreads();
}

DI void phase2(const Params& p, int layer, unsigned char* smem, int vb) {
    const int tid0 = opq(threadIdx.x);
  const int wave = tid0 >> 6, lane = tid0 & 63;
  bf16_t* vlds = (bf16_t*)smem + wave * VLDS_WAVE;
  const bool lru_first = blockIdx.x >= (gridDim.x >> 1);
  if (lru_first) { for (int item = blockIdx.x; item < 1024; item += gridDim.x) lru_local_item(p, layer, item, smem); }
  if ((gridDim.x & 7) == 0) {
    const int xcd = vb & 7, r0 = vb >> 3, rs = gridDim.x >> 3;
    for (int it = r0; it < 64; it += rs) sb_wave_item(p, (xcd * 64 + it) * 4 + wave, vlds, lane);
    for (int it = r0; it < 192; it += rs) dil_pair_item(p, (xcd * 192 + it) * 4 + wave, vlds, lane);
  } else {
    for (int item = blockIdx.x; item < 512; item += gridDim.x) sb_wave_item(p, item * 4 + wave, vlds, lane);
    for (int item = blockIdx.x; item < 1536; item += gridDim.x) dil_pair_item(p, item * 4 + wave, vlds, lane);
  }
  if (!lru_first) { for (int item = blockIdx.x; item < 1024; item += gridDim.x) lru_local_item(p, layer, item, smem); }
}

DI void phase2b(const Params& p, unsigned char* smem) {
  const int tid0 = opq(threadIdx.x);
  const int gtid = blockIdx.x * NTHREADS + tid0;
  const int gsz = gridDim.x * NTHREADS;
  const bool lru_first = blockIdx.x >= (gridDim.x >> 1);
#pragma unroll 1
  for (int step = 0; step < 2; ++step) {
  if ((step == 0) != lru_first) {
  for (int i = gtid; i < T * 64; i += gsz) {
    const int c8 = i & 7; const int hh = (i >> 3) & 7; const size_t tok = (size_t)(i >> 6);
    const float l0 = p.part_l[((size_t)0 * T + tok) * 8 + hh];
    const float l1 = p.part_l[((size_t)1 * T + tok) * 8 + hh];
    const float l2 = p.part_l[((size_t)2 * T + tok) * 8 + hh];
    const float mx = fmaxf(l0, fmaxf(l1, l2));
    float e0 = __builtin_amdgcn_exp2f(l0 - mx), e1 = __builtin_amdgcn_exp2f(l1 - mx), e2 = __builtin_amdgcn_exp2f(l2 - mx);
    const float inv = __builtin_amdgcn_rcpf(e0 + e1 + e2);
    e0 *= inv; e1 *= inv; e2 *= inv;
    const size_t oo = tok * 512 + hh * 64 + c8 * 8;
    const uint4 a0 = ld_nt16(p.part_o + (size_t)0 * T * 512 + oo);
    const uint4 a1 = ld_nt16(p.part_o + (size_t)1 * T * 512 + oo);
    const uint4 a2 = ld_nt16(p.part_o + (size_t)2 * T * 512 + oo);
    const uint4 gg = ld_nt16(p.proj + tok * DIN + OFF_AG + hh * 64 + c8 * 8);
    uint4 r;
    r.x = pack2((e0 * lo16(a0.x) + e1 * lo16(a1.x) + e2 * lo16(a2.x)) * siluf_(lo16(gg.x)), (e0 * hi16(a0.x) + e1 * hi16(a1.x) + e2 * hi16(a2.x)) * siluf_(hi16(gg.x)));
    r.y = pack2((e0 * lo16(a0.y) + e1 * lo16(a1.y) + e2 * lo16(a2.y)) * siluf_(lo16(gg.y)), (e0 * hi16(a0.y) + e1 * hi16(a1.y) + e2 * hi16(a2.y)) * siluf_(hi16(gg.y)));
    r.z = pack2((e0 * lo16(a0.z) + e1 * lo16(a1.z) + e2 * lo16(a2.z)) * siluf_(lo16(gg.z)), (e0 * hi16(a0.z) + e1 * hi16(a1.z) + e2 * hi16(a2.z)) * siluf_(hi16(gg.z)));
    r.w = pack2((e0 * lo16(a0.w) + e1 * lo16(a1.w) + e2 * lo16(a2.w)) * siluf_(lo16(gg.w)), (e0 * hi16(a0.w) + e1 * hi16(a1.w) + e2 * hi16(a2.w)) * siluf_(hi16(gg.w)));
    *(uint4*)(p.y + tok * DM + hh * 64 + c8 * 8) = r;
  }
  } else {
  float* carry_s = (float*)smem;
  for (int task = blockIdx.x; task < NB * NCH * 2; task += gridDim.x) {
    const int ch = tid0; const int half = task & 1; const int c = (task >> 1) & (NCH - 1); const int b = task >> 8;
    float carry = 0.f;
    for (int j0 = 0; j0 < c; j0 += 32) {
      float A[32], H[32];
#pragma unroll
      for (int u = 0; u < 32; ++u) {
        const bool ok = (j0 + u) < c;
        const size_t o = ((size_t)b * NCH + (ok ? (j0 + u) : 0)) * 256 + ch;
        const float a = p.aggA[o], hv = p.aggH[o];
        A[u] = ok ? a : 1.f; H[u] = ok ? hv : 0.f;
      }
#pragma unroll
      for (int u = 0; u < 32; ++u) carry = A[u] * carry + H[u];
    }
    __syncthreads();
    carry_s[ch] = carry;
    __syncthreads();
    const int cg = tid0 & 31, ts = tid0 >> 5;
    const float4 ca0 = *(const float4*)(carry_s + cg * 8), ca1 = *(const float4*)(carry_s + cg * 8 + 4);
    const size_t tok0 = (size_t)b * S + c * LCH + half * 32;
    uint4 hv4[4], cv4[4], gv4[4];
#pragma unroll
    for (int k = 0; k < 4; ++k) {
      const size_t tok = tok0 + ts + 8 * k;
      hv4[k] = ld_nt16(p.hloc + tok * 256 + cg * 8); cv4[k] = ld_nt16(p.cumA + tok * 256 + cg * 8); gv4[k] = ld_nt16(p.proj + tok * DIN + OFF_BG + cg * 8);
    }
#pragma unroll
    for (int k = 0; k < 4; ++k) {
      const size_t tok = tok0 + ts + 8 * k;
      const uint4 hq = hv4[k], cq = cv4[k], gq = gv4[k];
      uint4 r;
      r.x = pack2((lo16(hq.x) + lo16(cq.x) * ca0.x) * siluf_(lo16(gq.x)), (hi16(hq.x) + hi16(cq.x) * ca0.y) * siluf_(hi16(gq.x)));
      r.y = pack2((lo16(hq.y) + lo16(cq.y) * ca0.z) * siluf_(lo16(gq.y)), (hi16(hq.y) + hi16(cq.y) * ca0.w) * siluf_(hi16(gq.y)));
      r.z = pack2((lo16(hq.z) + lo16(cq.z) * ca1.x) * siluf_(lo16(gq.z)), (hi16(hq.z) + hi16(cq.z) * ca1.y) * siluf_(hi16(gq.z)));
      r.w = pack2((lo16(hq.w) + lo16(cq.w) * ca1.z) * siluf_(lo16(gq.w)), (hi16(hq.w) + hi16(cq.w) * ca1.w) * siluf_(hi16(gq.w)));
      *(uint4*)(p.y + tok * DM + 512 + cg * 8) = r;
    }
  }
  }
  }
}

DI void phase4(const Params& p) {
  const int tid0 = opq(threadIdx.x);
  const int gtid = blockIdx.x * NTHREADS + tid0;
  const int gsz = gridDim.x * NTHREADS;
  const int lane = tid0 & 63;
  const int gw = gtid >> 6, nw = gsz >> 6;
  const float4* g = (const float4*)p.final_gain;
  for (int row = gw; row < T; row += nw) {
    float ss = (lane < 16) ? p.part[(size_t)row * 16 + lane] : 0.f;
    const uint4* hrow = (const uint4*)(p.hn + (size_t)row * DM);
    uint4 hv[2];
#pragma unroll
    for (int m = 0; m < 2; ++m) hv[m] = ld_nt16(hrow + lane + 64 * m);
#pragma unroll
    for (int o = 8; o >= 1; o >>= 1) ss += __shfl_xor(ss, o);
    ss = __shfl(ss, 0);
    const float rs = rsqrtf(ss * (1.f / DM) + 1e-6f);
    float4* orow = (float4*)(p.out + (size_t)row * DM);
#pragma unroll
    for (int m = 0; m < 2; ++m) {
      const int f4 = 2 * (lane + 64 * m);
      const float4 g0 = g[f4], g1 = g[f4 + 1];
      float4 a, b;
      a.x = lo16(hv[m].x) * rs * g0.x; a.y = hi16(hv[m].x) * rs * g0.y; a.z = lo16(hv[m].y) * rs * g0.z; a.w = hi16(hv[m].y) * rs * g0.w;
      b.x = lo16(hv[m].z) * rs * g1.x; b.y = hi16(hv[m].z) * rs * g1.y; b.z = lo16(hv[m].w) * rs * g1.z; b.w = hi16(hv[m].w) * rs * g1.w;
      st_nt16(orow + f4, a);
      st_nt16(orow + f4 + 1, b);
    }
  }
}

#define XB_TMO      128
#define XB_XCNT(j)  (256  + 64 * (j))
#define XB_XSUB(j)  (1280 + 64 * (j))
#define XB_XGEN(j)  (2304 + 64 * (j))
#define XB_TOP      3328
#define XB_TOPGEN   3392
#define XCD_BAR_WORDS 3456
#define XB_SPIN_CAP (1u << 22)
#define LAS __attribute__((address_space(3)))
DI unsigned xb_ld(unsigned* p) { return __hip_atomic_load(p, __ATOMIC_RELAXED, __HIP_MEMORY_SCOPE_AGENT); }
DI unsigned xb_add(unsigned* p, unsigned v) { return __hip_atomic_fetch_add(p, v, __ATOMIC_RELAXED, __HIP_MEMORY_SCOPE_AGENT); }
DI unsigned xb_xcc_id() { return (unsigned)__builtin_amdgcn_s_getreg((3 << 11) | 20) & 0xFu; }
#define XB_SPIN(cond, bar) do { unsigned _sp = 0; while (cond) { __builtin_amdgcn_s_sleep(1); \
    if ((++_sp & 255u) == 0u) { if (xb_ld(&(bar)[XB_TMO])) break; if (_sp > XB_SPIN_CAP) { atomicAdd(&(bar)[XB_TMO], 1u); break; } } } } while (0)
struct XcdBarrier { unsigned* bar; unsigned x; volatile LAS unsigned* st; };
DI XcdBarrier xcd_barrier_post(unsigned* bar, volatile LAS unsigned* st) {
  XcdBarrier b; b.bar = bar; b.x = xb_xcc_id(); b.st = st;
  if (threadIdx.x == 0) (void)xb_add(&bar[XB_XCNT(b.x)], 1u);
  return b;
}
DI void xcd_barrier_complete(unsigned* bar, unsigned x, unsigned& nloc, unsigned& nx) {
  const unsigned G = gridDim.x * gridDim.y * gridDim.z;
  unsigned sum, cnt, mine, sp = 0u;
  for (;;) {
    sum = 0u; cnt = 0u; mine = 0u;
#pragma unroll
    for (unsigned j = 0; j < 16; ++j) { const unsigned c = xb_ld(&bar[XB_XCNT(j)]); sum += c; cnt += (c > 0u) ? 1u : 0u; mine = (j == x) ? c : mine; }
    if (sum == G) break;
    __builtin_amdgcn_s_sleep(1);
    if ((++sp & 255u) == 0u) { if (xb_ld(&bar[XB_TMO])) break; if (sp > XB_SPIN_CAP) { atomicAdd(&bar[XB_TMO], 1u); break; } }
  }
  nloc = mine > 0u ? mine : 1u; nx = cnt > 0u ? cnt : 1u;
}
DI void xcd_barrier(const XcdBarrier& b) {
  asm volatile("s_waitcnt vmcnt(0)" ::: "memory");
  __syncthreads();
  if (threadIdx.x == 0) {
    unsigned* bar = b.bar;
    unsigned bx = b.x;
    asm volatile("" : "+s"(bx));
    __builtin_amdgcn_s_waitcnt(0);
    unsigned nloc = b.st[0], nx = b.st[1];
    if (nloc == 0u) { xcd_barrier_complete(bar, bx, nloc, nx); b.st[0] = nloc; b.st[1] = nx; }
    const unsigned old = xb_add(&bar[XB_XSUB(bx)], 1u);
    const unsigned gen = old / nloc;
    if (old + 1u == (gen + 1u) * nloc) {
      __builtin_amdgcn_fence(__ATOMIC_RELEASE, "agent");
      asm volatile("s_waitcnt vmcnt(0)" ::: "memory");
      const unsigned og = xb_add(&bar[XB_TOP], 1u);
      const unsigned tg = og / nx;
      if (og + 1u == (tg + 1u) * nx) xb_add(&bar[XB_TOPGEN], 1u);
      else XB_SPIN(xb_ld(&bar[XB_TOPGEN]) == tg, bar);
      __builtin_amdgcn_fence(__ATOMIC_ACQUIRE, "agent");
      xb_add(&bar[XB_XGEN(bx)], 1u);
      asm volatile("s_waitcnt vmcnt(0)" ::: "memory");
    } else {
      XB_SPIN(xb_ld(&bar[XB_XGEN(bx)]) == gen, bar);
      __builtin_amdgcn_fence(__ATOMIC_ACQUIRE, "agent");
      asm volatile("s_waitcnt vmcnt(0)" ::: "memory");
    }
  }
  __syncthreads();
}


__global__ void __launch_bounds__(NTHREADS, 2) fwd_megakernel(Params p) {
  extern __shared__ __attribute__((aligned(16))) unsigned char smem[];
  uint4* xb_words = (uint4*)(smem + 3 * 24576 + 1024);
  if (threadIdx.x == 0) *xb_words = make_uint4(0u, 0u, 0u, 0u);
  __syncthreads();
  const XcdBarrier xb = xcd_barrier_post(p.bar, (volatile LAS unsigned*)xb_words);
  if (p.use_cg_sync) cg::this_grid().sync();
  phase0(p, smem);
  xcd_barrier(xb);
  const int vb = blockIdx.x;
  for (int layer = 0; layer < 2; ++layer) {
    gemm_phase<0>(p, layer, smem, vb);
    xcd_barrier(xb);
    phase2(p, layer, smem, vb);
    xcd_barrier(xb);
    phase2b(p, smem);
    xcd_barrier(xb);
    gemm_phase<1>(p, layer, smem, vb);
    xcd_barrier(xb);
  }
  phase4(p);
}

extern "C" void kernel_launch(void* const* d_in, const int* in_sizes, int n_in, void* d_out, int out_size,
                              void* d_ws, size_t ws_size, hipStream_t stream) {
  static int grid_blocks = 0;
  if (!grid_blocks) {
    int dev = 0, cus = 0, per_cu = 0;
    hipGetDevice(&dev);
    hipDeviceGetAttribute(&cus, hipDeviceAttributeMultiprocessorCount, dev);
    hipFuncSetAttribute((const void*)fwd_megakernel, hipFuncAttributeMaxDynamicSharedMemorySize, LDS_BYTES);
    hipOccupancyMaxActiveBlocksPerMultiprocessor(&per_cu, (const void*)fwd_megakernel, NTHREADS, LDS_BYTES);
    if (per_cu < 1) per_cu = 1;
    if (per_cu > 2) per_cu = 2;
    grid_blocks = cus * per_cu;
  }
  Params p{};
  p.x = (const float*)d_in[0]; p.norm_gain = (const float*)d_in[1]; p.w_in = (const float*)d_in[2];
  p.conv_w = (const float*)d_in[3]; p.conv_b = (const float*)d_in[4];
  p.gaw = (const float*)d_in[5]; p.gab = (const float*)d_in[6]; p.gxw = (const float*)d_in[7]; p.gxb = (const float*)d_in[8];
  p.lam = (const float*)d_in[9]; p.w_out = (const float*)d_in[10]; p.final_gain = (const float*)d_in[11];
  p.out = (float*)d_out;
  unsigned char* ws = (unsigned char*)d_ws;
  size_t off = 0;
  auto take = [&](size_t bytes) { unsigned char* r = ws + off; off += (bytes + 255) & ~(size_t)255; return r; };
  p.winT = (bf16_t*)take((size_t)2 * DIN * DM * 2);
  p.woutT = (bf16_t*)take((size_t)2 * DM * DM * 2);
  p.proj = (bf16_t*)take((size_t)T * DIN * 2);
  p.y = (bf16_t*)take((size_t)T * DM * 2);
  p.hloc = (bf16_t*)take((size_t)T * 256 * 2);
  p.cumA = (bf16_t*)take((size_t)T * 256 * 2);
  p.aggA = (float*)take((size_t)NB * NCH * 256 * 4);
  p.aggH = (float*)take((size_t)NB * NCH * 256 * 4);
  p.part = (float*)take((size_t)T * 16 * 4);
  p.rope = (float2*)take((size_t)S * 8 * 8);
  p.part_l = (float*)take((size_t)3 * T * 8 * 4);
  p.bar = (unsigned*)take((size_t)XCD_BAR_WORDS * 4);
  p.gwT = (bf16_t*)take((size_t)2 * 2 * 4 * 64 * 64 * 2);
  p.use_cg_sync = 0; p.pad_ = 0;
  p.hn = (bf16_t*)take((size_t)T * DM * 2);
  p.part_o = (bf16_t*)d_out;
  if (off > ws_size) { fprintf(stderr, "workspace too small: need %zu have %zu\n", off, ws_size); return; }
  if (hipMemsetAsync(p.bar, 0, (size_t)XCD_BAR_WORDS * 4, stream) != hipSuccess) { fprintf(stderr, "memset of barrier words failed\n"); return; }
  void* args[] = {&p};
  hipError_t e = hipLaunchCooperativeKernel((const void*)fwd_megakernel, dim3(grid_blocks), dim3(NTHREADS), args, LDS_BYTES, stream);
  if (e != hipSuccess) fprintf(stderr, "cooperative launch failed: %s (grid %d)\n", hipGetErrorString(e), grid_blocks);
}
```

```cpp
#include <hip/hip_runtime.h>
#include <hip/hip_cooperative_groups.h>
#include <cstdio>
namespace cg = cooperative_groups;

#define DI __device__ __forceinline__
typedef unsigned short bf16_t;
using bf16x8 = __attribute__((ext_vector_type(8))) short;
using f32x16 = __attribute__((ext_vector_type(16))) float;

constexpr int S = 8192, NB = 2, T = NB * S, DM = 1024, DIN = 3584;
constexpr int OFF_AQ = 0, OFF_AK = 512, OFF_AV = 1024, OFF_AG = 1536, OFF_BX = 2048, OFF_BG = 2304,
              OFF_CQ = 2560, OFF_CK = 2816, OFF_CV = 3072, OFF_CG = 3328;
constexpr int LCH = 64;
constexpr int NCH = S / LCH;
constexpr int LDS_BYTES = 3 * 24576 + 1024 + 16;
constexpr int NTHREADS = 256;

struct Params {
  const float *x, *norm_gain, *w_in, *conv_w, *conv_b, *gaw, *gab, *gxw, *gxb, *lam, *w_out, *final_gain;
  float* out;
  bf16_t *winT, *woutT, *proj, *y, *hn, *part_o, *gwT;
  float *aggA, *aggH, *part, *part_l;
  bf16_t *hloc, *cumA;
  float2* rope;
  unsigned* bar;
  int use_cg_sync; int pad_;
};

typedef __bf16 bf16x2_t __attribute__((ext_vector_type(2)));
typedef float f32x2 __attribute__((ext_vector_type(2)));
DI unsigned cvt_pk(float a, float b) { f32x2 v = {a, b}; return __builtin_bit_cast(unsigned, __builtin_convertvector(v, bf16x2_t)); }
DI bf16_t f2bf(float x) { return (bf16_t)(cvt_pk(x, 0.f) & 0xffffu); }
DI float bf2f(bf16_t h) { return __uint_as_float(((unsigned)h) << 16); }
DI unsigned pack2(float a, float b) { return cvt_pk(a, b); }
DI float lo16(unsigned u) { return __uint_as_float(u << 16); }
DI float hi16(unsigned u) { return __uint_as_float(u & 0xffff0000u); }
DI float x32_other(float x, int h) {
  const auto rr = __builtin_amdgcn_permlane32_swap(__float_as_uint(x), __float_as_uint(x), false, false);
  return __uint_as_float(h ? rr[0] : rr[1]);
}
DI float x32_max(float x) { const auto rr = __builtin_amdgcn_permlane32_swap(__float_as_uint(x), __float_as_uint(x), false, false); return fmaxf(__uint_as_float(rr[0]), __uint_as_float(rr[1])); }
DI float x32_sum(float x) { const auto rr = __builtin_amdgcn_permlane32_swap(__float_as_uint(x), __float_as_uint(x), false, false); return __uint_as_float(rr[0]) + __uint_as_float(rr[1]); }
typedef unsigned u32x4n __attribute__((ext_vector_type(4)));
typedef float f32x4n __attribute__((ext_vector_type(4)));
typedef unsigned u32x2n __attribute__((ext_vector_type(2)));
DI uint4 ld_nt16(const void* p) { const u32x4n v = __builtin_nontemporal_load((const u32x4n*)p); return make_uint4(v[0], v[1], v[2], v[3]); }
DI uint2 ld_nt8(const void* p) { const u32x2n v = __builtin_nontemporal_load((const u32x2n*)p); return make_uint2(v[0], v[1]); }
DI float4 ld_nt_f4(const void* p) { const f32x4n v = __builtin_nontemporal_load((const f32x4n*)p); return make_float4(v[0], v[1], v[2], v[3]); }
DI float ld_nt_f(const float* p) { return __builtin_nontemporal_load(p); }
DI bf16_t ld_nt_h(const bf16_t* p) { return __builtin_nontemporal_load(p); }
DI void st_nt16(void* p, float4 v) { f32x4n w = {v.x, v.y, v.z, v.w}; __builtin_nontemporal_store(w, (f32x4n*)p); }
DI void st_pair16(bf16_t* row_base_lane, int k, uint2 a, uint2 b) {
  const auto rx = __builtin_amdgcn_permlane32_swap(a.x, b.x, false, false);
  const auto ry = __builtin_amdgcn_permlane32_swap(a.y, b.y, false, false);
  *(uint4*)(row_base_lane + 8 * k) = make_uint4(rx[0], ry[0], rx[1], ry[1]);
}
DI void ld_pair16(const bf16_t* row_base_lane, int k, uint2& a, uint2& b) {
  const uint4 q = *(const uint4*)(row_base_lane + 8 * k);
  const auto rx = __builtin_amdgcn_permlane32_swap(q.x, q.z, false, false);
  const auto ry = __builtin_amdgcn_permlane32_swap(q.y, q.w, false, false);
  a = make_uint2(rx[0], ry[0]); b = make_uint2(rx[1], ry[1]);
}
DI int opq(int v) { asm volatile("" : "+v"(v)); return v; }
DI float sigmoidf_(float x) { return 1.f / (1.f + __expf(-x)); }
DI float siluf_(float x) { return x * __builtin_amdgcn_rcpf(1.f + __builtin_amdgcn_exp2f(-1.4426950408889634f * x)); }

DI void phase0(const Params& p, unsigned char* smem) {
  const int tid0 = opq(threadIdx.x);
  const int gtid = blockIdx.x * NTHREADS + tid0;
  const int gsz = gridDim.x * NTHREADS;
  const bool rows_first = blockIdx.x >= (gridDim.x >> 1);
#pragma unroll 1
  for (int step = 0; step < 2; ++step) {
  if ((step == 0) != rows_first) {
  {
    bf16_t* tl = (bf16_t*)smem;
    const int tid = tid0;
    for (int task = blockIdx.x; task < 2 * 16 * 56 + 2 * 16 * 16; task += gridDim.x) {
      const bool is_in = task < 2 * 16 * 56;
      const int tt = is_in ? task : task - 2 * 16 * 56;
      const int NBL = is_in ? 56 : 16;
      const int N = is_in ? DIN : DM;
      const int nb = tt % NBL; const int kb = (tt / NBL) & 15; const int l = tt / (NBL * 16);
      const float* src = (is_in ? p.w_in : p.w_out) + (size_t)l * DM * N + (size_t)(kb * 64) * N + nb * 64;
      bf16_t* dst = (is_in ? p.winT : p.woutT) + ((size_t)l * N + nb * 64) * DM + kb * 64;
      __syncthreads();
      const int n4 = tid & 15, k0 = (tid >> 4) * 4;
      float4 tv[4];
#pragma unroll
      for (int r = 0; r < 4; ++r) tv[r] = ld_nt_f4(src + (size_t)(k0 + r) * N + n4 * 4);
      if (is_in) {
        const float4 gk = *(const float4*)(p.norm_gain + l * DM + kb * 64 + k0);
        tv[0].x *= gk.x; tv[0].y *= gk.x; tv[0].z *= gk.x; tv[0].w *= gk.x;
        tv[1].x *= gk.y; tv[1].y *= gk.y; tv[1].z *= gk.y; tv[1].w *= gk.y;
        tv[2].x *= gk.z; tv[2].y *= gk.z; tv[2].z *= gk.z; tv[2].w *= gk.z;
        tv[3].x *= gk.w; tv[3].y *= gk.w; tv[3].z *= gk.w; tv[3].w *= gk.w;
      }
      *(uint2*)(tl + (n4 * 4 + 0) * 72 + k0) = make_uint2(pack2(tv[0].x, tv[1].x), pack2(tv[2].x, tv[3].x));
      *(uint2*)(tl + (n4 * 4 + 1) * 72 + k0) = make_uint2(pack2(tv[0].y, tv[1].y), pack2(tv[2].y, tv[3].y));
      *(uint2*)(tl + (n4 * 4 + 2) * 72 + k0) = make_uint2(pack2(tv[0].z, tv[1].z), pack2(tv[2].z, tv[3].z));
      *(uint2*)(tl + (n4 * 4 + 3) * 72 + k0) = make_uint2(pack2(tv[0].w, tv[1].w), pack2(tv[2].w, tv[3].w));
      __syncthreads();
#pragma unroll
      for (int ps = 0; ps < 2; ++ps) {
        const int idx = tid + 256 * ps; const int n = idx >> 3, kc = idx & 7;
        *(uint4*)(dst + (size_t)n * DM + kc * 8) = *(const uint4*)(tl + n * 72 + kc * 8);
      }
    }
  }
  } else {
  for (int i = gtid; i < 2 * 2 * 4 * 64 * 64; i += gsz) {
    const int d = i & 63, e = (i >> 6) & 63, n = (i >> 12) & 3, gate = (i >> 14) & 1, l = i >> 15;
    const float* src = gate ? p.gxw : p.gaw;
    p.gwT[i] = f2bf(src[(((size_t)l * 4 + n) * 64 + d) * 64 + e]);
  }
  for (int i = gtid; i < S * 8; i += gsz) {
    const int pos = i >> 3, f = i & 7;
    float invf;
    switch (f) {
      case 0: invf = 1.0f; break;
      case 1: invf = 0.19392274474868576f; break;
      case 2: invf = 0.03760603093086393f; break;
      case 3: invf = 0.007292664737217109f; break;
      case 4: invf = 0.001414213562373095f; break;
      case 5: invf = 0.0002742481756762073f; break;
      case 6: invf = 5.318295896944988e-05f; break;
      default: invf = 1.031338537721246e-05f; break;
    }
    const float ang = (float)pos * invf;
    const double a = (double)ang;
    const double k = rint(a * 0.15915494309189535);
    const float r = (float)(a - k * 6.283185307179586);
    p.rope[i] = make_float2(__cosf(r), __sinf(r));
  }
  const int lane = tid0 & 63;
  const int gw = gtid >> 6, nw = gsz >> 6;
  for (int row = gw; row < T; row += 2 * nw) {
    const int row2 = row + nw;
    const bool has2 = row2 < T;
    const float4* xr = (const float4*)(p.x + (size_t)row * DM);
    const float4* xr2 = (const float4*)(p.x + (size_t)(has2 ? row2 : row) * DM);
    float4 v[4], v2[4];
#pragma unroll
    for (int j = 0; j < 4; ++j) { const int f4 = 2 * lane + (j & 1) + 128 * (j >> 1); v[j] = ld_nt_f4(xr + f4); v2[j] = ld_nt_f4(xr2 + f4); }
    float ss = 0.f, ss2 = 0.f;
#pragma unroll
    for (int j = 0; j < 4; ++j) {
      ss += v[j].x * v[j].x + v[j].y * v[j].y + v[j].z * v[j].z + v[j].w * v[j].w;
      ss2 += v2[j].x * v2[j].x + v2[j].y * v2[j].y + v2[j].z * v2[j].z + v2[j].w * v2[j].w;
    }
#pragma unroll
    for (int o = 32; o >= 1; o >>= 1) { ss += __shfl_xor(ss, o); ss2 += __shfl_xor(ss2, o); }
    const float rs = rsqrtf(ss * (1.f / DM) + 1e-6f), rs2 = rsqrtf(ss2 * (1.f / DM) + 1e-6f);
    uint4* hr = (uint4*)(p.hn + (size_t)row * DM);
#pragma unroll
    for (int m = 0; m < 2; ++m)
      hr[lane + 64 * m] = make_uint4(pack2(v[2 * m].x * rs, v[2 * m].y * rs), pack2(v[2 * m].z * rs, v[2 * m].w * rs),
                                     pack2(v[2 * m + 1].x * rs, v[2 * m + 1].y * rs), pack2(v[2 * m + 1].z * rs, v[2 * m + 1].w * rs));
    if (has2) {
      uint4* hr2 = (uint4*)(p.hn + (size_t)row2 * DM);
#pragma unroll
      for (int m = 0; m < 2; ++m)
        hr2[lane + 64 * m] = make_uint4(pack2(v2[2 * m].x * rs2, v2[2 * m].y * rs2), pack2(v2[2 * m].z * rs2, v2[2 * m].w * rs2),
                                        pack2(v2[2 * m + 1].x * rs2, v2[2 * m + 1].y * rs2), pack2(v2[2 * m + 1].z * rs2, v2[2 * m + 1].w * rs2));
    }
  }
  }
  }
}

DI void phaseN(const Params& p) {
  const int tid0 = opq(threadIdx.x);
  const int gtid = blockIdx.x * NTHREADS + tid0;
  const int gsz = gridDim.x * NTHREADS;
  const int lane = tid0 & 63;
  const int gw = gtid >> 6, nw = gsz >> 6;
  for (int row = gw; row < T; row += nw) {
    float ss = (lane < 16) ? p.part[(size_t)row * 16 + lane] : 0.f;
#pragma unroll
    for (int o = 8; o >= 1; o >>= 1) ss += __shfl_xor(ss, o);
    ss = __shfl(ss, 0);
    const float rs = rsqrtf(ss * (1.f / DM) + 1e-6f);
    const float4* xr = (const float4*)(p.out + (size_t)row * DM);
    uint2* hr = (uint2*)(p.hn + (size_t)row * DM);
#pragma unroll
    for (int j = 0; j < 4; ++j) {
      const float4 v = xr[lane + 64 * j];
      hr[lane + 64 * j] = make_uint2(pack2(v.x * rs, v.y * rs), pack2(v.z * rs, v.w * rs));
    }
  }
}

constexpr int LR2 = 40;
constexpr int NKT = DM / 32;
constexpr int GST = 24576;
constexpr int RSTD_OFF = 3 * GST;
constexpr int XBW_OFF = RSTD_OFF + 1024;
#define RAW_BARRIER() do { __builtin_amdgcn_s_waitcnt(0xC07F);   __builtin_amdgcn_s_barrier(); } while (0)
template <int MODE>
DI void gemm_phase(const Params& p, int layer, unsigned char* smem, int vb) {
  float* rstd_s = (float*)(smem + RSTD_OFF);
  const int tid = opq(threadIdx.x), lane = tid & 63, w = tid >> 6;
  const int wr = w >> 1, wc = w & 1;
  const int l31 = lane & 31, lh = lane >> 5;
  constexpr int NCT = (MODE == 0) ? (DIN / 128) : (DM / 128);
  constexpr int NTILES = (T / 256) * NCT;
  const bf16_t* Ab = (MODE == 0) ? p.hn : p.y;
  const bf16_t* Bt = (MODE == 0) ? (p.winT + (size_t)layer * DIN * DM) : (p.woutT + (size_t)layer * DM * DM);
  const int swz = (l31 >> 2) & 3;
  const int c0 = ((lh) ^ swz) * 16, c1 = ((2 + lh) ^ swz) * 16;
  const int aoff = (wr * 128 + l31) * 64, boff = 16384 + (wc * 64 + l31) * 64;

  const bool swzo = (gridDim.x % 8) == 0;
  const int nper = swzo ? (NTILES / 8) : NTILES;
  const int istart = swzo ? (vb >> 3) : vb;
  const int istep = swzo ? (gridDim.x >> 3) : gridDim.x;
  for (int it = istart; it < nper; it += istep) {
    int rt, ct;
    if (swzo) { rt = (vb & 7) * 8 + (it & 7); ct = it >> 3; }
    else { rt = it / NCT; ct = it % NCT; }
    const int row0 = rt * 256, col0 = ct * 128;
    f32x16 acc[4][2];
#pragma unroll
    for (int i = 0; i < 4; ++i)
#pragma unroll
      for (int j = 0; j < 2; ++j)
#pragma unroll
        for (int r = 0; r < 16; ++r) acc[i][j][r] = 0.f;

    const char* gp[6];
#pragma unroll
    for (int i = 0; i < 6; ++i) {
      const int q = w * 6 + i;
      const int trow = ((q < 16) ? q : (q - 16)) * 16 + (lane >> 2);
      const int chunk = (lane & 3) ^ ((trow >> 2) & 3);
      const bf16_t* src = (q < 16) ? (Ab + (size_t)(row0 + trow) * DM) : (Bt + (size_t)(col0 + trow) * DM);
      gp[i] = (const char*)(src + chunk * 8);
    }
#define GLDS(KT, ST) do { _Pragma("unroll") for (int i_ = 0; i_ < 6; ++i_) \
      __builtin_amdgcn_global_load_lds((const unsigned*)(gp[i_] + (KT) * 64), (unsigned*)(smem + (ST) * GST + (w * 6 + i_) * 1024), 16, 0, 0); } while (0)
    bf16x8 fa0, fa1, fa2, fa3, fb0, fb1, ga0, ga1, ga2, ga3, gb0, gb1;
#define READS0(ST) do { const unsigned char* sb_ = smem + (ST) * GST; \
      fb0 = *(const bf16x8*)(sb_ + boff + c0); fb1 = *(const bf16x8*)(sb_ + boff + 2048 + c0); \
      fa0 = *(const bf16x8*)(sb_ + aoff + c0); fa1 = *(const bf16x8*)(sb_ + aoff + 2048 + c0); fa2 = *(const bf16x8*)(sb_ + aoff + 4096 + c0); fa3 = *(const bf16x8*)(sb_ + aoff + 6144 + c0); } while (0)
#define READS1(ST) do { const unsigned char* sb_ = smem + (ST) * GST; \
      gb0 = *(const bf16x8*)(sb_ + boff + c1); gb1 = *(const bf16x8*)(sb_ + boff + 2048 + c1); \
      ga0 = *(const bf16x8*)(sb_ + aoff + c1); ga1 = *(const bf16x8*)(sb_ + aoff + 2048 + c1); ga2 = *(const bf16x8*)(sb_ + aoff + 4096 + c1); ga3 = *(const bf16x8*)(sb_ + aoff + 6144 + c1); } while (0)
#define MM(AF, BF, I, J) acc[I][J] = __builtin_amdgcn_mfma_f32_32x32x16_bf16(BF, AF, acc[I][J], 0, 0, 0)
#define MFMA0() do { MM(fa0, fb0, 0, 0); MM(fa0, fb1, 0, 1); MM(fa1, fb0, 1, 0); MM(fa1, fb1, 1, 1); MM(fa2, fb0, 2, 0); MM(fa2, fb1, 2, 1); MM(fa3, fb0, 3, 0); MM(fa3, fb1, 3, 1); } while (0)
#define MFMA1() do { MM(ga0, gb0, 0, 0); MM(ga0, gb1, 0, 1); MM(ga1, gb0, 1, 0); MM(ga1, gb1, 1, 1); MM(ga2, gb0, 2, 0); MM(ga2, gb1, 2, 1); MM(ga3, gb0, 3, 0); MM(ga3, gb1, 3, 1); } while (0)
    RAW_BARRIER();
    float4 qa_ = make_float4(0.f, 0.f, 0.f, 0.f), qb_ = qa_, qc_ = qa_, qd_ = qa_;
    if (MODE == 0 && layer > 0) {
      const float4* pp = (const float4*)(p.part + (size_t)(row0 + tid) * 16);
      qa_ = pp[0]; qb_ = pp[1]; qc_ = pp[2]; qd_ = pp[3];
    }
    GLDS(0, 0);
    GLDS(1, 1);
    if (MODE == 0 && layer > 0) {
      const float ss = qa_.x + qa_.y + qa_.z + qa_.w + qb_.x + qb_.y + qb_.z + qb_.w + qc_.x + qc_.y + qc_.z + qc_.w + qd_.x + qd_.y + qd_.z + qd_.w;
      rstd_s[tid] = rsqrtf(ss * (1.f / DM) + 1e-6f);
    }
    float pf0 = 0.f, pf1 = 0.f, pf2 = 0.f, pf3 = 0.f;
    if (MODE == 1 && layer == 0) {
      const float* xb = p.x + (size_t)(row0 + wr * 128 + l31) * DM + col0 + wc * 64 + lh * 32;
      pf0 = xb[0]; pf1 = xb[(size_t)32 * DM]; pf2 = xb[(size_t)64 * DM]; pf3 = xb[(size_t)96 * DM];
    }
    asm volatile("s_waitcnt vmcnt(6)" ::: "memory");
    RAW_BARRIER();
    GLDS(2, 2);
    READS0(0);
    MFMA0();
    READS1(0);
    __builtin_amdgcn_sched_barrier(0);
    int st = 1;
#pragma unroll 1
    for (int kt = 1; kt < NKT - 1; ++kt) {
      asm volatile("s_waitcnt vmcnt(6)" ::: "memory");
      RAW_BARRIER();
      const int stn = (st == 0) ? 2 : (st - 1);
      __builtin_amdgcn_s_setprio(1);
      GLDS((kt + 2 < NKT) ? (kt + 2) : (NKT - 1), stn);
      READS0(st);
      MFMA1();
      MFMA0();
      READS1(st);
      __builtin_amdgcn_sched_group_barrier(0x100, 6, 0);
      __builtin_amdgcn_sched_group_barrier(0x008, 10, 0);
      __builtin_amdgcn_sched_group_barrier(0x100, 6, 0);
      __builtin_amdgcn_sched_group_barrier(0x008, 6, 0);
      __builtin_amdgcn_s_setprio(0);
      __builtin_amdgcn_sched_barrier(0);
      st = (st == 2) ? 0 : (st + 1);
    }
    asm volatile("s_waitcnt vmcnt(0)" ::: "memory");
    RAW_BARRIER();
    READS0(st);
    MFMA1();
    MFMA0();
    READS1(st);
    __builtin_amdgcn_sched_group_barrier(0x100, 6, 0);
    __builtin_amdgcn_sched_group_barrier(0x008, 10, 0);
    __builtin_amdgcn_sched_group_barrier(0x100, 6, 0);
    __builtin_amdgcn_sched_group_barrier(0x008, 6, 0);
    __builtin_amdgcn_sched_barrier(0);
    MFMA1();
    asm volatile("" :: "v"(pf0), "v"(pf1), "v"(pf2), "v"(pf3));
    if (MODE == 0) {
      const int gcolw = col0 + wc * 64;
      const bool do_rope = gcolw < 1024;
      const bool qscale = (gcolw < 512) || (gcolw >= OFF_CQ && gcolw < OFF_CK);
#pragma unroll
      for (int i = 0; i < 4; ++i) {
        const int lrw = wr * 128 + i * 32 + l31;
        const int grow = row0 + lrw;
        float sc = qscale ? 0.18033688011112042f : 1.f;
        if (layer > 0) sc *= rstd_s[lrw];
        bf16_t* dstp = p.proj + (size_t)grow * DIN + gcolw + 8 * lh;
        uint2 og[2][4];
#pragma unroll
        for (int j = 0; j < 2; ++j)
#pragma unroll
          for (int g = 0; g < 4; ++g) {
            og[j][g].x = pack2(acc[i][j][4 * g + 0] * sc, acc[i][j][4 * g + 1] * sc);
            og[j][g].y = pack2(acc[i][j][4 * g + 2] * sc, acc[i][j][4 * g + 3] * sc);
          }
        if (do_rope) {
          const float4* tab = (const float4*)(p.rope + (size_t)(grow & (S - 1)) * 8 + 4 * lh);
          const float4 cs01 = tab[0], cs23 = tab[1];
          const float c0r = cs01.x, s0r = cs01.y, c1r = cs01.z, s1r = cs01.w, c2r = cs23.x, s2r = cs23.y, c3r = cs23.z, s3r = cs23.w;
          const float x10 = acc[i][0][0] * sc, x11 = acc[i][0][1] * sc, x12 = acc[i][0][2] * sc, x13 = acc[i][0][3] * sc;
          const float x20 = acc[i][0][4] * sc, x21 = acc[i][0][5] * sc, x22 = acc[i][0][6] * sc, x23 = acc[i][0][7] * sc;
          og[0][0].x = pack2(x10 * c0r - x20 * s0r, x11 * c1r - x21 * s1r); og[0][0].y = pack2(x12 * c2r - x22 * s2r, x13 * c3r - x23 * s3r);
          og[0][1].x = pack2(x20 * c0r + x10 * s0r, x21 * c1r + x11 * s1r); og[0][1].y = pack2(x22 * c2r + x12 * s2r, x23 * c3r + x13 * s3r);
        }
#pragma unroll
        for (int j = 0; j < 2; ++j) {
          st_pair16(dstp + j * 32, 0, og[j][0], og[j][1]);
          st_pair16(dstp + j * 32, 2, og[j][2], og[j][3]);
        }
        __builtin_amdgcn_sched_barrier(0);
      }
    } else {
#pragma unroll
      for (int i = 0; i < 4; ++i) {
        const int lrw = wr * 128 + i * 32 + l31;
        const int grow = row0 + lrw;
        const size_t ob = (size_t)grow * DM + col0 + wc * 64 + 4 * lh;
        float ss = 0.f;
        bf16_t* hrow = p.hn + (size_t)grow * DM + col0 + wc * 64 + 8 * lh;
#pragma unroll
        for (int j = 0; j < 2; ++j) {
          uint2 og[4];
          uint2 hbv[4] = {make_uint2(0u, 0u), make_uint2(0u, 0u), make_uint2(0u, 0u), make_uint2(0u, 0u)};
          if (layer != 0) { ld_pair16(hrow + j * 32, 0, hbv[0], hbv[1]); ld_pair16(hrow + j * 32, 2, hbv[2], hbv[3]); }
#pragma unroll
          for (int g = 0; g < 4; ++g) {
            const size_t o = ob + j * 32 + 8 * g;
            float4 rv;
            if (layer == 0) rv = *(const float4*)(p.x + o);
            else { const uint2 hb = hbv[g]; rv = make_float4(lo16(hb.x), hi16(hb.x), lo16(hb.y), hi16(hb.y)); }
            float4 v;
            v.x = acc[i][j][4 * g + 0] + rv.x; v.y = acc[i][j][4 * g + 1] + rv.y; v.z = acc[i][j][4 * g + 2] + rv.z; v.w = acc[i][j][4 * g + 3] + rv.w;
            og[g] = make_uint2(pack2(v.x, v.y), pack2(v.z, v.w));
            ss += v.x * v.x + v.y * v.y + v.z * v.z + v.w * v.w;
          }
          st_pair16(hrow + j * 32, 0, og[0], og[1]);
          st_pair16(hrow + j * 32, 2, og[2], og[3]);
        }
        ss = x32_sum(ss);
        if (lh == 0) p.part[(size_t)grow * 16 + ct * 2 + wc] = ss;
        __builtin_amdgcn_sched_barrier(0);
      }
    }
  }
}

typedef short s16x4 __attribute__((ext_vector_type(4)));
typedef unsigned u32x4 __attribute__((ext_vector_type(4)));
constexpr int VROW = 72;
constexpr int VLDS_WAVE = 32 * VROW;

DI bf16x8 pack8f(float a0, float a1, float a2, float a3, float a4, float a5, float a6, float a7) {
  u32x4 r = {cvt_pk(a0, a1), cvt_pk(a2, a3), cvt_pk(a4, a5), cvt_pk(a6, a7)};
  return __builtin_bit_cast(bf16x8, r);
}
DI s16x4 tr_read(const bf16_t* lds_ptr) {
  return __builtin_amdgcn_ds_read_tr16_b64_v4i16((__attribute__((address_space(3))) s16x4*)(lds_ptr));
}
DI bf16x8 vt_frag(const bf16_t* vlds, int lane, int dt, int s) {
  const int h = lane >> 5, blk = (lane >> 4) & 1, qq = (lane & 15) >> 2, pp = lane & 3;
  const bf16_t* a = vlds + (16 * s + 4 * h + qq) * VROW + 32 * dt + 16 * blk + 4 * pp;
  const s16x4 lo = tr_read(a);
  const s16x4 hi = tr_read(a + 8 * VROW);
  return __builtin_shufflevector(lo, hi, 0, 1, 2, 3, 4, 5, 6, 7);
}
struct VRegs { uint4 v0, v1, v2, v3; };
DI VRegs load_v(const bf16_t* src0, size_t row_stride, int lane) {
  const bf16_t* src = src0 + (size_t)(lane >> 3) * row_stride + (lane & 7) * 8;
  VRegs r;
  r.v0 = *(const uint4*)(src);
  r.v1 = *(const uint4*)(src + 8 * row_stride);
  r.v2 = *(const uint4*)(src + 16 * row_stride);
  r.v3 = *(const uint4*)(src + 24 * row_stride);
  return r;
}
DI void store_v(bf16_t* vlds, const VRegs& r, int lane) {
  bf16_t* dst = vlds + (lane >> 3) * VROW + (lane & 7) * 8;
  *(uint4*)(dst) = r.v0; *(uint4*)(dst + 8 * VROW) = r.v1; *(uint4*)(dst + 16 * VROW) = r.v2; *(uint4*)(dst + 24 * VROW) = r.v3;
}
struct KRegs { bf16x8 k0, k1, k2, k3; };
DI KRegs load_k(const bf16_t* rowptr) {
  KRegs r;
  r.k0 = *(const bf16x8*)(rowptr); r.k1 = *(const bf16x8*)(rowptr + 16); r.k2 = *(const bf16x8*)(rowptr + 32); r.k3 = *(const bf16x8*)(rowptr + 48);
  return r;
}

DI void sb_wave_item(const Params& p, int witem, bf16_t* vlds, int lane) {
  const int l31 = lane & 31, h = lane >> 5;
  const int qt = 255 - (witem & 255); const int hh = (witem >> 8) & 3; const int b = witem >> 10;
  const bf16_t* base = p.proj + (size_t)b * S * DIN;
  const int t = qt * 32 + l31;
  bf16x8 qf[4];
#pragma unroll
  for (int ks = 0; ks < 4; ++ks) qf[ks] = *(const bf16x8*)(base + (size_t)t * DIN + OFF_CQ + hh * 64 + ks * 16 + h * 8);
  f32x16 o0, o1;
#pragma unroll
  for (int r = 0; r < 16; ++r) { o0[r] = 0.f; o1[r] = 0.f; }
  float carry = 0.f;
  const bf16_t* kbase = base + (size_t)l31 * DIN + OFF_CK + hh * 64 + h * 8;
  const bf16_t* vbase = base + OFF_CV + hh * 64;
  KRegs kc = load_k(kbase + (size_t)(qt * 32) * DIN);
  VRegs vc = load_v(vbase + (size_t)(qt * 32) * DIN, DIN, lane);
  for (int kt = qt; kt >= 0; --kt) {
    store_v(vlds, vc, lane);
    const KRegs kcur = kc;
    __builtin_amdgcn_sched_barrier(0);
    {
      const int ktn = (kt > 0) ? (kt - 1) : 0;
      kc = load_k(kbase + (size_t)(ktn * 32) * DIN);
      vc = load_v(vbase + (size_t)(ktn * 32) * DIN, DIN, lane);
    }
    __builtin_amdgcn_sched_barrier(0);
    f32x16 sacc;
#pragma unroll
    for (int r = 0; r < 16; ++r) sacc[r] = 0.f;
    sacc = __builtin_amdgcn_mfma_f32_32x32x16_bf16(kcur.k0, qf[0], sacc, 0, 0, 0);
    sacc = __builtin_amdgcn_mfma_f32_32x32x16_bf16(kcur.k1, qf[1], sacc, 0, 0, 0);
    sacc = __builtin_amdgcn_mfma_f32_32x32x16_bf16(kcur.k2, qf[2], sacc, 0, 0, 0);
    sacc = __builtin_amdgcn_mfma_f32_32x32x16_bf16(kcur.k3, qf[3], sacc, 0, 0, 0);
    const bool diag = (kt == qt);
    float lk[16], zs[16];
#pragma unroll
    for (int r = 0; r < 16; ++r) {
      const float z = sacc[r];
      const float e = __builtin_amdgcn_exp2f(-fabsf(z));
      const float sp = fmaxf(z, 0.f) + __builtin_amdgcn_logf(1.f + e);
      const bool valid = !diag || ((8 * (r >> 2) + 4 * h + (r & 3)) < l31);
      lk[r] = valid ? -sp : 0.f;
      zs[r] = valid ? (z - sp) : -INFINITY;
    }
    float Gt[4], Pt[4], ex[16];
#pragma unroll
    for (int g = 0; g < 4; ++g) {
      ex[4 * g + 3] = 0.f;
      ex[4 * g + 2] = lk[4 * g + 3];
      ex[4 * g + 1] = ex[4 * g + 2] + lk[4 * g + 2];
      ex[4 * g + 0] = ex[4 * g + 1] + lk[4 * g + 1];
      Gt[g] = ex[4 * g + 0] + lk[4 * g + 0];
      Pt[g] = x32_other(Gt[g], h);
    }
    const float T0 = Gt[0] + Pt[0], T1 = Gt[1] + Pt[1], T2 = Gt[2] + Pt[2], T3 = Gt[3] + Pt[3];
    float U[4];
    U[3] = 0.f; U[2] = T3; U[1] = U[2] + T2; U[0] = U[1] + T1;
    float w[16];
#pragma unroll
    for (int g = 0; g < 4; ++g) {
      const float after = carry + U[g] + (h == 0 ? Pt[g] : 0.f);
#pragma unroll
      for (int i = 0; i < 4; ++i) w[4 * g + i] = __builtin_amdgcn_exp2f(zs[4 * g + i] + (after + ex[4 * g + i]));
    }
    carry += U[0] + T0;
    const bf16x8 pf0 = pack8f(w[0], w[1], w[2], w[3], w[4], w[5], w[6], w[7]);
    const bf16x8 pf1 = pack8f(w[8], w[9], w[10], w[11], w[12], w[13], w[14], w[15]);
    o0 = __builtin_amdgcn_mfma_f32_32x32x16_bf16(vt_frag(vlds, lane, 0, 0), pf0, o0, 0, 0, 0);
    o1 = __builtin_amdgcn_mfma_f32_32x32x16_bf16(vt_frag(vlds, lane, 1, 0), pf0, o1, 0, 0, 0);
    o0 = __builtin_amdgcn_mfma_f32_32x32x16_bf16(vt_frag(vlds, lane, 0, 1), pf1, o0, 0, 0, 0);
    o1 = __builtin_amdgcn_mfma_f32_32x32x16_bf16(vt_frag(vlds, lane, 1, 1), pf1, o1, 0, 0, 0);
    if (__ballot(carry >= -152.f) == 0ull) break;
  }
  const bf16_t* grow = base + (size_t)t * DIN + OFF_CG + hh * 64;
  bf16_t* yrow = p.y + ((size_t)b * S + t) * DM + 768 + hh * 64 + 8 * h;
  uint2 r0[4], r1[4];
#pragma unroll
  for (int g = 0; g < 4; ++g) {
    const int d0 = 8 * g + 4 * h;
    const uint2 g0 = *(const uint2*)(grow + d0);
    const uint2 g1 = *(const uint2*)(grow + 32 + d0);
    r0[g].x = cvt_pk(o0[4 * g + 0] * siluf_(lo16(g0.x)), o0[4 * g + 1] * siluf_(hi16(g0.x)));
    r0[g].y = cvt_pk(o0[4 * g + 2] * siluf_(lo16(g0.y)), o0[4 * g + 3] * siluf_(hi16(g0.y)));
    r1[g].x = cvt_pk(o1[4 * g + 0] * siluf_(lo16(g1.x)), o1[4 * g + 1] * siluf_(hi16(g1.x)));
    r1[g].y = cvt_pk(o1[4 * g + 2] * siluf_(lo16(g1.y)), o1[4 * g + 3] * siluf_(hi16(g1.y)));
  }
  st_pair16(yrow, 0, r0[0], r0[1]); st_pair16(yrow, 2, r0[2], r0[3]);
  st_pair16(yrow + 32, 0, r1[0], r1[1]); st_pair16(yrow + 32, 2, r1[2], r1[3]);
}

template <bool MASK>
DI void dil_softmax_step(const f32x16& sacc, int dt32, int l31, int h, float& m, float& lsum, f32x16& o0, f32x16& o1, bf16x8& pf0, bf16x8& pf1) {
  const int base = dt32 + l31 - 4 * h;
  float mt = -1e30f;
#pragma unroll
  for (int r = 0; r < 16; ++r) {
    const bool valid = !MASK || ((unsigned)(base - ((r & 3) + 8 * (r >> 2))) <= 128u);
    mt = fmaxf(mt, valid ? sacc[r] : -1e30f);
  }
  mt = x32_max(mt);
  const float mn = fmaxf(m, mt);
  const float corr = __builtin_amdgcn_exp2f(m - mn);
  m = mn;
  float ps = 0.f;
  float w[16];
#pragma unroll
  for (int r = 0; r < 16; ++r) {
    const bool valid = !MASK || ((unsigned)(base - ((r & 3) + 8 * (r >> 2))) <= 128u);
    w[r] = valid ? __builtin_amdgcn_exp2f(sacc[r] - mn) : 0.f;
    ps += w[r];
  }
  lsum = lsum * corr + ps;
#pragma unroll
  for (int r = 0; r < 16; ++r) { o0[r] *= corr; o1[r] *= corr; }
  pf0 = pack8f(w[0], w[1], w[2], w[3], w[4], w[5], w[6], w[7]);
  pf1 = pack8f(w[8], w[9], w[10], w[11], w[12], w[13], w[14], w[15]);
}
DI void dil_write_out(const Params& p, int pat, size_t tok, int hh, int h, float m, float lsum, const f32x16& o0, const f32x16& o1) {
  const float ltot = x32_sum(lsum);
  const float inv = 1.f / ltot;
  if (h == 0) p.part_l[((size_t)pat * T + tok) * 8 + hh] = m + __builtin_amdgcn_logf(ltot);
  bf16_t* orow = p.part_o + ((size_t)pat * T + tok) * 512 + hh * 64 + 8 * h;
  uint2 r0[4], r1[4];
#pragma unroll
  for (int g = 0; g < 4; ++g) {
    r0[g].x = cvt_pk(o0[4 * g + 0] * inv, o0[4 * g + 1] * inv);
    r0[g].y = cvt_pk(o0[4 * g + 2] * inv, o0[4 * g + 3] * inv);
    r1[g].x = cvt_pk(o1[4 * g + 0] * inv, o1[4 * g + 1] * inv);
    r1[g].y = cvt_pk(o1[4 * g + 2] * inv, o1[4 * g + 3] * inv);
  }
  st_pair16(orow, 0, r0[0], r0[1]); st_pair16(orow, 2, r0[2], r0[3]);
  st_pair16(orow + 32, 0, r1[0], r1[1]); st_pair16(orow + 32, 2, r1[2], r1[3]);
}
DI void dil_pair_item(const Params& p, int witem, bf16_t* vlds, int lane) {
  const int l31 = lane & 31, h = lane >> 5;
  const int idx = witem & 127; int rest = witem >> 7; const int pat = rest % 3; rest /= 3; const int hh = rest & 7; const int b = rest >> 3;
  const int dsh = 2 * pat, dil = 1 << dsh;
  const int res = idx & (dil - 1), jt0 = (idx >> dsh) * 2;
  const bf16_t* base = p.proj + (size_t)b * S * DIN;
  const int ta = res + dil * (jt0 * 32 + l31);
  const int tb = ta + dil * 32;
  bf16x8 qa[4], qb[4];
#pragma unroll
  for (int ks = 0; ks < 4; ++ks) {
    qa[ks] = *(const bf16x8*)(base + (size_t)ta * DIN + OFF_AQ + hh * 64 + ks * 16 + h * 8);
    qb[ks] = *(const bf16x8*)(base + (size_t)tb * DIN + OFF_AQ + hh * 64 + ks * 16 + h * 8);
  }
  f32x16 oa0, oa1, ob0, ob1;
#pragma unroll
  for (int r = 0; r < 16; ++r) { oa0[r] = 0.f; oa1[r] = 0.f; ob0[r] = 0.f; ob1[r] = 0.f; }
  float ma = -1e30f, la = 0.f, mb = -1e30f, lb = 0.f;
  const int kt_lo = (jt0 - 4 > 0) ? (jt0 - 4) : 0;
  const int kt_hi = jt0 + 1;
  const bf16_t* kbase = base + (size_t)(res + dil * l31) * DIN + OFF_AK + hh * 64 + h * 8;
  const bf16_t* vbase = base + (size_t)res * DIN + OFF_AV + hh * 64;
  const size_t tstride = (size_t)dil * 32 * DIN;
  KRegs kc = load_k(kbase + (size_t)kt_lo * tstride);
  VRegs vc = load_v(vbase + (size_t)kt_lo * tstride, (size_t)dil * DIN, lane);
  for (int kt = kt_lo; kt <= kt_hi; ++kt) {
    store_v(vlds, vc, lane);
    const KRegs kcur = kc;
    __builtin_amdgcn_sched_barrier(0);
    {
      const int ktn = (kt < kt_hi) ? (kt + 1) : kt_hi;
      kc = load_k(kbase + (size_t)ktn * tstride);
      vc = load_v(vbase + (size_t)ktn * tstride, (size_t)dil * DIN, lane);
    }
    __builtin_amdgcn_sched_barrier(0);
    f32x16 sa, sb;
#pragma unroll
    for (int r = 0; r < 16; ++r) { sa[r] = 0.f; sb[r] = 0.f; }
    sa = __builtin_amdgcn_mfma_f32_32x32x16_bf16(kcur.k0, qa[0], sa, 0, 0, 0);
    sb = __builtin_amdgcn_mfma_f32_32x32x16_bf16(kcur.k0, qb[0], sb, 0, 0, 0);
    sa = __builtin_amdgcn_mfma_f32_32x32x16_bf16(kcur.k1, qa[1], sa, 0, 0, 0);
    sb = __builtin_amdgcn_mfma_f32_32x32x16_bf16(kcur.k1, qb[1], sb, 0, 0, 0);
    sa = __builtin_amdgcn_mfma_f32_32x32x16_bf16(kcur.k2, qa[2], sa, 0, 0, 0);
    sb = __builtin_amdgcn_mfma_f32_32x32x16_bf16(kcur.k2, qb[2], sb, 0, 0, 0);
    sa = __builtin_amdgcn_mfma_f32_32x32x16_bf16(kcur.k3, qa[3], sa, 0, 0, 0);
    sb = __builtin_amdgcn_mfma_f32_32x32x16_bf16(kcur.k3, qb[3], sb, 0, 0, 0);
    const int da = jt0 - kt, db = da + 1;
    const bf16x8 v00 = vt_frag(vlds, lane, 0, 0), v10 = vt_frag(vlds, lane, 1, 0);
    const bf16x8 v01 = vt_frag(vlds, lane, 0, 1), v11 = vt_frag(vlds, lane, 1, 1);
    if (da >= 0) {
      bf16x8 pa0, pa1;
      if (da >= 1 && da <= 3) dil_softmax_step<false>(sa, da * 32, l31, h, ma, la, oa0, oa1, pa0, pa1);
      else dil_softmax_step<true>(sa, da * 32, l31, h, ma, la, oa0, oa1, pa0, pa1);
      oa0 = __builtin_amdgcn_mfma_f32_32x32x16_bf16(v00, pa0, oa0, 0, 0, 0);
      oa1 = __builtin_amdgcn_mfma_f32_32x32x16_bf16(v10, pa0, oa1, 0, 0, 0);
      oa0 = __builtin_amdgcn_mfma_f32_32x32x16_bf16(v01, pa1, oa0, 0, 0, 0);
      oa1 = __builtin_amdgcn_mfma_f32_32x32x16_bf16(v11, pa1, oa1, 0, 0, 0);
    }
    if (db <= 4) {
      bf16x8 pb0, pb1;
      if (db >= 1 && db <= 3) dil_softmax_step<false>(sb, db * 32, l31, h, mb, lb, ob0, ob1, pb0, pb1);
      else dil_softmax_step<true>(sb, db * 32, l31, h, mb, lb, ob0, ob1, pb0, pb1);
      ob0 = __builtin_amdgcn_mfma_f32_32x32x16_bf16(v00, pb0, ob0, 0, 0, 0);
      ob1 = __builtin_amdgcn_mfma_f32_32x32x16_bf16(v10, pb0, ob1, 0, 0, 0);
      ob0 = __builtin_amdgcn_mfma_f32_32x32x16_bf16(v01, pb1, ob0, 0, 0, 0);
      ob1 = __builtin_amdgcn_mfma_f32_32x32x16_bf16(v11, pb1, ob1, 0, 0, 0);
    }
  }
  dil_write_out(p, pat, (size_t)b * S + ta, hh, h, ma, la, oa0, oa1);
  dil_write_out(p, pat, (size_t)b * S + tb, hh, h, mb, lb, ob0, ob1);
}

DI void lru_local_item(const Params& p, int layer, int item, unsigned char* smem) {
  bf16_t* xs = (bf16_t*)smem;
  bf16_t* xcb = xs + 67 * 72;
  float* xcf = (float*)(xcb + 64 * 72);
  float* a_s = xcf + 64 * 65;
  float* u_s = a_s + 64 * 64;
  const int n = item & 3; const int c = (item >> 2) & (NCH - 1); const int b = item >> 9;
  const int tid = opq(threadIdx.x); const int e = tid & 63; const int tq = tid >> 6;
  const int lane = tid & 63, l31 = lane & 31, h = lane >> 5, w = tid >> 6;
  const int ch = n * 64 + e;
  const int t0 = c * LCH;
  const bf16_t* base = p.proj + (size_t)b * S * DIN + OFF_BX + n * 64;
  __syncthreads();
  for (int ci = tid; ci < 67 * 8; ci += NTHREADS) {
    const int r = ci >> 3, c8 = ci & 7; const int t = t0 - 3 + r;
    uint4 v = make_uint4(0u, 0u, 0u, 0u);
    if (t >= 0) v = *(const uint4*)(base + (size_t)t * DIN + c8 * 8);
    *(uint4*)(xs + r * 72 + c8 * 8) = v;
  }
  const float* cw = p.conv_w + layer * 4 * 256;
  const float w0 = cw[0 * 256 + ch], w1 = cw[1 * 256 + ch], w2 = cw[2 * 256 + ch], w3 = cw[3 * 256 + ch];
  const float cb = p.conv_b[layer * 256 + ch];
  __syncthreads();
#pragma unroll
  for (int j = 0; j < 16; ++j) {
    const int tt = tq + 4 * j;
    const float acc = cb + w0 * bf2f(xs[tt * 72 + e]) + w1 * bf2f(xs[(tt + 1) * 72 + e]) + w2 * bf2f(xs[(tt + 2) * 72 + e]) + w3 * bf2f(xs[(tt + 3) * 72 + e]);
    xcf[tt * 65 + e] = acc;
    xcb[tt * 72 + e] = f2bf(acc);
  }
  __syncthreads();
  {
    const int qi = w >> 1, qj = w & 1;
    const bf16_t* wa = p.gwT + (((size_t)(layer * 2 + 0) * 4 + n) * 64 + 32 * qj + l31) * 64 + 8 * h;
    const bf16_t* wx = p.gwT + (((size_t)(layer * 2 + 1) * 4 + n) * 64 + 32 * qj + l31) * 64 + 8 * h;
    f32x16 acc_a, acc_x;
#pragma unroll
    for (int r = 0; r < 16; ++r) { acc_a[r] = 0.f; acc_x[r] = 0.f; }
#pragma unroll
    for (int ks = 0; ks < 4; ++ks) {
      const bf16x8 af = *(const bf16x8*)(xcb + (32 * qi + l31) * 72 + 16 * ks + 8 * h);
      const bf16x8 ba = *(const bf16x8*)(wa + 16 * ks);
      const bf16x8 bx = *(const bf16x8*)(wx + 16 * ks);
      acc_a = __builtin_amdgcn_mfma_f32_32x32x16_bf16(af, ba, acc_a, 0, 0, 0);
      acc_x = __builtin_amdgcn_mfma_f32_32x32x16_bf16(af, bx, acc_x, 0, 0, 0);
    }
    const int ee = 32 * qj + l31; const int che = n * 64 + ee;
    const float ba_ = p.gab[layer * 256 + che], bx_ = p.gxb[layer * 256 + che];
    const float lam = p.lam[layer * 256 + che];
    const float el = __builtin_amdgcn_exp2f(-1.4426950408889634f * fabsf(lam));
    const float l1p = (el < 0.03f) ? el * (1.f - el * (0.5f - el * (0.33333334f - el * 0.25f))) : 0.6931471805599453f * __builtin_amdgcn_logf(1.f + el);
    const float lsl = fminf(lam, 0.f) - l1p;
#pragma unroll
    for (int r = 0; r < 16; ++r) {
      const int tt = 32 * qi + (r & 3) + 8 * (r >> 2) + 4 * h;
      const float rg = __builtin_amdgcn_rcpf(1.f + __builtin_amdgcn_exp2f(-1.4426950408889634f * (acc_a[r] + ba_)));
      const float ig = __builtin_amdgcn_rcpf(1.f + __builtin_amdgcn_exp2f(-1.4426950408889634f * (acc_x[r] + bx_)));
      const float log_a = 8.f * rg * lsl;
      const float a = __builtin_amdgcn_exp2f(1.4426950408889634f * log_a);
      const float x2 = 2.f * log_a;
      const float om_series = -x2 * (1.f + x2 * (0.5f + x2 * (0.16666667f + x2 * (0.041666668f + x2 * 0.008333334f))));
      const float om = (x2 > -0.125f) ? om_series : (1.f - a * a);
      const float u = __builtin_amdgcn_sqrtf(om) * (ig * xcf[tt * 65 + ee]);
      a_s[tt * 64 + ee] = a; u_s[tt * 64 + ee] = u;
    }
  }
  __syncthreads();
  bf16_t* hs = xs;
  bf16_t* cs = xcb;
  if (tid < 64) {
    float hh = 0.f, A = 1.f;
    for (int tt = 0; tt < LCH; ++tt) {
      const float a = a_s[tt * 64 + e], u = u_s[tt * 64 + e];
      hh = a * hh + u; A *= a;
      hs[tt * 64 + e] = f2bf(hh); cs[tt * 64 + e] = f2bf(A);
    }
    p.aggA[((size_t)b * NCH + c) * 256 + ch] = A;
    p.aggH[((size_t)b * NCH + c) * 256 + ch] = hh;
  }
  __syncthreads();
#pragma unroll
  for (int k = 0; k < 2; ++k) {
    const int ci = tid + k * NTHREADS; const int tt = ci >> 3, c8 = ci & 7;
    const size_t o = ((size_t)b * S + t0 + tt) * 256 + n * 64 + c8 * 8;
    *(uint4*)(p.hloc + o) = *(const uint4*)(hs + tt * 64 + c8 * 8);
    *(uint4*)(p.cumA + o) = *(const uint4*)(cs + tt * 64 + c8 * 8);
  }
  __syncthreads();
}

DI void phase2(const Params& p, int layer, unsigned char* smem, int vb) {
    const int tid0 = opq(threadIdx.x);
  const int wave = tid0 >> 6, lane = tid0 & 63;
  bf16_t* vlds = (bf16_t*)smem + wave * VLDS_WAVE;
  const bool lru_first = blockIdx.x >= (gridDim.x >> 1);
  if (lru_first) { for (int item = blockIdx.x; item < 1024; item += gridDim.x) lru_local_item(p, layer, item, smem); }
  if ((gridDim.x & 7) == 0) {
    const int xcd = vb & 7, r0 = vb >> 3, rs = gridDim.x >> 3;
    for (int it = r0; it < 64; it += rs) sb_wave_item(p, (xcd * 64 + it) * 4 + wave, vlds, lane);
    for (int it = r0; it < 192; it += rs) dil_pair_item(p, (xcd * 192 + it) * 4 + wave, vlds, lane);
  } else {
    for (int item = blockIdx.x; item < 512; item += gridDim.x) sb_wave_item(p, item * 4 + wave, vlds, lane);
    for (int item = blockIdx.x; item < 1536; item += gridDim.x) dil_pair_item(p, item * 4 + wave, vlds, lane);
  }
  if (!lru_first) { for (int item = blockIdx.x; item < 1024; item += gridDim.x) lru_local_item(p, layer, item, smem); }
}

DI void phase2b(const Params& p, unsigned char* smem) {
  const int tid0 = opq(threadIdx.x);
  const int gtid = blockIdx.x * NTHREADS + tid0;
  const int gsz = gridDim.x * NTHREADS;
  const bool lru_first = blockIdx.x >= (gridDim.x >> 1);
#pragma unroll 1
  for (int step = 0; step < 2; ++step) {
  if ((step == 0) != lru_first) {
  for (int i = gtid; i < T * 64; i += gsz) {
    const int c8 = i & 7; const int hh = (i >> 3) & 7; const size_t tok = (size_t)(i >> 6);
    const float l0 = p.part_l[((size_t)0 * T + tok) * 8 + hh];
    const float l1 = p.part_l[((size_t)1 * T + tok) * 8 + hh];
    const float l2 = p.part_l[((size_t)2 * T + tok) * 8 + hh];
    const float mx = fmaxf(l0, fmaxf(l1, l2));
    float e0 = __builtin_amdgcn_exp2f(l0 - mx), e1 = __builtin_amdgcn_exp2f(l1 - mx), e2 = __builtin_amdgcn_exp2f(l2 - mx);
    const float inv = __builtin_amdgcn_rcpf(e0 + e1 + e2);
    e0 *= inv; e1 *= inv; e2 *= inv;
    const size_t oo = tok * 512 + hh * 64 + c8 * 8;
    const uint4 a0 = ld_nt16(p.part_o + (size_t)0 * T * 512 + oo);
    const uint4 a1 = ld_nt16(p.part_o + (size_t)1 * T * 512 + oo);
    const uint4 a2 = ld_nt16(p.part_o + (size_t)2 * T * 512 + oo);
    const uint4 gg = ld_nt16(p.proj + tok * DIN + OFF_AG + hh * 64 + c8 * 8);
    uint4 r;
    r.x = pack2((e0 * lo16(a0.x) + e1 * lo16(a1.x) + e2 * lo16(a2.x)) * siluf_(lo16(gg.x)), (e0 * hi16(a0.x) + e1 * hi16(a1.x) + e2 * hi16(a2.x)) * siluf_(hi16(gg.x)));
    r.y = pack2((e0 * lo16(a0.y) + e1 * lo16(a1.y) + e2 * lo16(a2.y)) * siluf_(lo16(gg.y)), (e0 * hi16(a0.y) + e1 * hi16(a1.y) + e2 * hi16(a2.y)) * siluf_(hi16(gg.y)));
    r.z = pack2((e0 * lo16(a0.z) + e1 * lo16(a1.z) + e2 * lo16(a2.z)) * siluf_(lo16(gg.z)), (e0 * hi16(a0.z) + e1 * hi16(a1.z) + e2 * hi16(a2.z)) * siluf_(hi16(gg.z)));
    r.w = pack2((e0 * lo16(a0.w) + e1 * lo16(a1.w) + e2 * lo16(a2.w)) * siluf_(lo16(gg.w)), (e0 * hi16(a0.w) + e1 * hi16(a1.w) + e2 * hi16(a2.w)) * siluf_(hi16(gg.w)));
    *(uint4*)(p.y + tok * DM + hh * 64 + c8 * 8) = r;
  }
  } else {
  float* carry_s = (float*)smem;
  for (int task = blockIdx.x; task < NB * NCH * 2; task += gridDim.x) {
    const int ch = tid0; const int half = task & 1; const int c = (task >> 1) & (NCH - 1); const int b = task >> 8;
    float carry = 0.f;
    for (int j0 = 0; j0 < c; j0 += 32) {
      float A[32], H[32];
#pragma unroll
      for (int u = 0; u < 32; ++u) {
        const bool ok = (j0 + u) < c;
        const size_t o = ((size_t)b * NCH + (ok ? (j0 + u) : 0)) * 256 + ch;
        const float a = p.aggA[o], hv = p.aggH[o];
        A[u] = ok ? a : 1.f; H[u] = ok ? hv : 0.f;
      }
#pragma unroll
      for (int u = 0; u < 32; ++u) carry = A[u] * carry + H[u];
    }
    __syncthreads();
    carry_s[ch] = carry;
    __syncthreads();
    const int cg = tid0 & 31, ts = tid0 >> 5;
    const float4 ca0 = *(const float4*)(carry_s + cg * 8), ca1 = *(const float4*)(carry_s + cg * 8 + 4);
    const size_t tok0 = (size_t)b * S + c * LCH + half * 32;
    uint4 hv4[4], cv4[4], gv4[4];
#pragma unroll
    for (int k = 0; k < 4; ++k) {
      const size_t tok = tok0 + ts + 8 * k;
      hv4[k] = ld_nt16(p.hloc + tok * 256 + cg * 8); cv4[k] = ld_nt16(p.cumA + tok * 256 + cg * 8); gv4[k] = ld_nt16(p.proj + tok * DIN + OFF_BG + cg * 8);
    }
#pragma unroll
    for (int k = 0; k < 4; ++k) {
      const size_t tok = tok0 + ts + 8 * k;
      const uint4 hq = hv4[k], cq = cv4[k], gq = gv4[k];
      uint4 r;
      r.x = pack2((lo16(hq.x) + lo16(cq.x) * ca0.x) * siluf_(lo16(gq.x)), (hi16(hq.x) + hi16(cq.x) * ca0.y) * siluf_(hi16(gq.x)));
      r.y = pack2((lo16(hq.y) + lo16(cq.y) * ca0.z) * siluf_(lo16(gq.y)), (hi16(hq.y) + hi16(cq.y) * ca0.w) * siluf_(hi16(gq.y)));
      r.z = pack2((lo16(hq.z) + lo16(cq.z) * ca1.x) * siluf_(lo16(gq.z)), (hi16(hq.z) + hi16(cq.z) * ca1.y) * siluf_(hi16(gq.z)));
      r.w = pack2((lo16(hq.w) + lo16(cq.w) * ca1.z) * siluf_(lo16(gq.w)), (hi16(hq.w) + hi16(cq.w) * ca1.w) * siluf_(hi16(gq.w)));
      *(uint4*)(p.y + tok * DM + 512 + cg * 8) = r;
    }
  }
  }
  }
}

DI void phase4(const Params& p) {
  const int tid0 = opq(threadIdx.x);
  const int gtid = blockIdx.x * NTHREADS + tid0;
  const int gsz = gridDim.x * NTHREADS;
  const int lane = tid0 & 63;
  const int gw = gtid >> 6, nw = gsz >> 6;
  const float4* g = (const float4*)p.final_gain;
  for (int row = gw; row < T; row += nw) {
    float ss = (lane < 16) ? p.part[(size_t)row * 16 + lane] : 0.f;
    const uint4* hrow = (const uint4*)(p.hn + (size_t)row * DM);
    uint4 hv[2];
#pragma unroll
    for (int m = 0; m < 2; ++m) hv[m] = ld_nt16(hrow + lane + 64 * m);
#pragma unroll
    for (int o = 8; o >= 1; o >>= 1) ss += __shfl_xor(ss, o);
    ss = __shfl(ss, 0);
    const float rs = rsqrtf(ss * (1.f / DM) + 1e-6f);
    float4* orow = (float4*)(p.out + (size_t)row * DM);
#pragma unroll
    for (int m = 0; m < 2; ++m) {
      const int f4 = 2 * (lane + 64 * m);
      const float4 g0 = g[f4], g1 = g[f4 + 1];
      float4 a, b;
      a.x = lo16(hv[m].x) * rs * g0.x; a.y = hi16(hv[m].x) * rs * g0.y; a.z = lo16(hv[m].y) * rs * g0.z; a.w = hi16(hv[m].y) * rs * g0.w;
      b.x = lo16(hv[m].z) * rs * g1.x; b.y = hi16(hv[m].z) * rs * g1.y; b.z = lo16(hv[m].w) * rs * g1.z; b.w = hi16(hv[m].w) * rs * g1.w;
      st_nt16(orow + f4, a);
      st_nt16(orow + f4 + 1, b);
    }
  }
}

#define XB_TMO      128
#define XB_XCNT(j)  (256  + 64 * (j))
#define XB_XSUB(j)  (1280 + 64 * (j))
#define XB_XGEN(j)  (2304 + 64 * (j))
#define XB_TOP      3328
#define XB_TOPGEN   3392
#define XCD_BAR_WORDS 3456
#define XB_SPIN_CAP (1u << 22)
#define LAS __attribute__((address_space(3)))
DI unsigned xb_ld(unsigned* p) { return __hip_atomic_load(p, __ATOMIC_RELAXED, __HIP_MEMORY_SCOPE_AGENT); }
DI unsigned xb_add(unsigned* p, unsigned v) { return __hip_atomic_fetch_add(p, v, __ATOMIC_RELAXED, __HIP_MEMORY_SCOPE_AGENT); }
DI unsigned xb_xcc_id() { return (unsigned)__builtin_amdgcn_s_getreg((3 << 11) | 20) & 0xFu; }
#define XB_SPIN(cond, bar) do { unsigned _sp = 0; while (cond) { __builtin_amdgcn_s_sleep(1); \
    if ((++_sp & 255u) == 0u) { if (xb_ld(&(bar)[XB_TMO])) break; if (_sp > XB_SPIN_CAP) { atomicAdd(&(bar)[XB_TMO], 1u); break; } } } } while (0)
struct XcdBarrier { unsigned* bar; unsigned x; volatile LAS unsigned* st; };
DI XcdBarrier xcd_barrier_post(unsigned* bar, volatile LAS unsigned* st) {
  XcdBarrier b; b.bar = bar; b.x = xb_xcc_id(); b.st = st;
  if (threadIdx.x == 0) (void)xb_add(&bar[XB_XCNT(b.x)], 1u);
  return b;
}
DI void xcd_barrier_complete(unsigned* bar, unsigned x, unsigned& nloc, unsigned& nx) {
  const unsigned G = gridDim.x * gridDim.y * gridDim.z;
  unsigned sum, cnt, mine, sp = 0u;
  for (;;) {
    sum = 0u; cnt = 0u; mine = 0u;
#pragma unroll
    for (unsigned j = 0; j < 16; ++j) { const unsigned c = xb_ld(&bar[XB_XCNT(j)]); sum += c; cnt += (c > 0u) ? 1u : 0u; mine = (j == x) ? c : mine; }
    if (sum == G) break;
    __builtin_amdgcn_s_sleep(1);
    if ((++sp & 255u) == 0u) { if (xb_ld(&bar[XB_TMO])) break; if (sp > XB_SPIN_CAP) { atomicAdd(&bar[XB_TMO], 1u); break; } }
  }
  nloc = mine > 0u ? mine : 1u; nx = cnt > 0u ? cnt : 1u;
}
DI void xcd_barrier(const XcdBarrier& b) {
  asm volatile("s_waitcnt vmcnt(0)" ::: "memory");
  __syncthreads();
  if (threadIdx.x == 0) {
    unsigned* bar = b.bar;
    unsigned bx = b.x;
    asm volatile("" : "+s"(bx));
    __builtin_amdgcn_s_waitcnt(0);
    unsigned nloc = b.st[0], nx = b.st[1];
    if (nloc == 0u) { xcd_barrier_complete(bar, bx, nloc, nx); b.st[0] = nloc; b.st[1] = nx; }
    const unsigned old = xb_add(&bar[XB_XSUB(bx)], 1u);
    const unsigned gen = old / nloc;
    if (old + 1u == (gen + 1u) * nloc) {
      __builtin_amdgcn_fence(__ATOMIC_RELEASE, "agent");
      asm volatile("s_waitcnt vmcnt(0)" ::: "memory");
      const unsigned og = xb_add(&bar[XB_TOP], 1u);
      const unsigned tg = og / nx;
      if (og + 1u == (tg + 1u) * nx) xb_add(&bar[XB_TOPGEN], 1u);
      else XB_SPIN(xb_ld(&bar[XB_TOPGEN]) == tg, bar);
      __builtin_amdgcn_fence(__ATOMIC_ACQUIRE, "agent");
      xb_add(&bar[XB_XGEN(bx)], 1u);
      asm volatile("s_waitcnt vmcnt(0)" ::: "memory");
    } else {
      XB_SPIN(xb_ld(&bar[XB_XGEN(bx)]) == gen, bar);
      __builtin_amdgcn_fence(__ATOMIC_ACQUIRE, "agent");
      asm volatile("s_waitcnt vmcnt(0)" ::: "memory");
    }
  }
  __syncthreads();
}


__global__ void __launch_bounds__(NTHREADS, 2) fwd_megakernel(Params p) {
  extern __shared__ __attribute__((aligned(16))) unsigned char smem[];
  uint4* xb_words = (uint4*)(smem + 3 * 24576 + 1024);
  if (threadIdx.x == 0) *xb_words = make_uint4(0u, 0u, 0u, 0u);
  __syncthreads();
  const XcdBarrier xb = xcd_barrier_post(p.bar, (volatile LAS unsigned*)xb_words);
  if (p.use_cg_sync) cg::this_grid().sync();
  phase0(p, smem);
  xcd_barrier(xb);
  const int vb = blockIdx.x;
  for (int layer = 0; layer < 2; ++layer) {
    gemm_phase<0>(p, layer, smem, vb);
    xcd_barrier(xb);
    phase2(p, layer, smem, vb);
    xcd_barrier(xb);
    phase2b(p, smem);
    xcd_barrier(xb);
    gemm_phase<1>(p, layer, smem, vb);
    xcd_barrier(xb);
  }
  phase4(p);
}

extern "C" void kernel_launch(void* const* d_in, const int* in_sizes, int n_in, void* d_out, int out_size,
                              void* d_ws, size_t ws_size, hipStream_t stream) {
  static int grid_blocks = 0;
  if (!grid_blocks) {
    int dev = 0, cus = 0, per_cu = 0;
    hipGetDevice(&dev);
    hipDeviceGetAttribute(&cus, hipDeviceAttributeMultiprocessorCount, dev);
    hipFuncSetAttribute((const void*)fwd_megakernel, hipFuncAttributeMaxDynamicSharedMemorySize, LDS_BYTES);
    hipOccupancyMaxActiveBlocksPerMultiprocessor(&per_cu, (const void*)fwd_megakernel, NTHREADS, LDS_BYTES);
    if (per_cu < 1) per_cu = 1;
    if (per_cu > 2) per_cu = 2;
    grid_blocks = cus * per_cu;
  }
  Params p{};
  p.x = (const float*)d_in[0]; p.norm_gain = (const float*)d_in[1]; p.w_in = (const float*)d_in[2];
  p.conv_w = (const float*)d_in[3]; p.conv_b = (const float*)d_in[4];
  p.gaw = (const float*)d_in[5]; p.gab = (const float*)d_in[6]; p.gxw = (const float*)d_in[7]; p.gxb = (const float*)d_in[8];
  p.lam = (const float*)d_in[9]; p.w_out = (const float*)d_in[10]; p.final_gain = (const float*)d_in[11];
  p.out = (float*)d_out;
  unsigned char* ws = (unsigned char*)d_ws;
  size_t off = 0;
  auto take = [&](size_t bytes) { unsigned char* r = ws + off; off += (bytes + 255) & ~(size_t)255; return r; };
  p.winT = (bf16_t*)take((size_t)2 * DIN * DM * 2);
  p.woutT = (bf16_t*)take((size_t)2 * DM * DM * 2);
  p.proj = (bf16_t*)take((size_t)T * DIN * 2);
  p.y = (bf16_t*)take((size_t)T * DM * 2);
  p.hloc = (bf16_t*)take((size_t)T * 256 * 2);
  p.cumA = (bf16_t*)take((size_t)T * 256 * 2);
  p.aggA = (float*)take((size_t)NB * NCH * 256 * 4);
  p.aggH = (float*)take((size_t)NB * NCH * 256 * 4);
  p.part = (float*)take((size_t)T * 16 * 4);
  p.rope = (float2*)take((size_t)S * 8 * 8);
  p.part_l = (float*)take((size_t)3 * T * 8 * 4);
  p.bar = (unsigned*)take((size_t)XCD_BAR_WORDS * 4);
  p.gwT = (bf16_t*)take((size_t)2 * 2 * 4 * 64 * 64 * 2);
  p.use_cg_sync = 0; p.pad_ = 0;
  p.hn = (bf16_t*)take((size_t)T * DM * 2);
  p.part_o = (bf16_t*)d_out;
  if (off > ws_size) { fprintf(stderr, "workspace too small: need %zu have %zu\n", off, ws_size); return; }
  if (hipMemsetAsync(p.bar, 0, (size_t)XCD_BAR_WORDS * 4, stream) != hipSuccess) { fprintf(stderr, "memset of barrier words failed\n"); return; }
  void* args[] = {&p};
  hipError_t e = hipLaunchCooperativeKernel((const void*)fwd_megakernel, dim3(grid_blocks), dim3(NTHREADS), args, LDS_BYTES, stream);
  if (e != hipSuccess) fprintf(stderr, "cooperative launch failed: %s (grid %d)\n", hipGetErrorString(e), grid_blocks);
}
```
